# Optimizing an MI355X kernel written in HIP

```python
import jax, jax.numpy as jnp
from jax import lax
import numpy as np

D_MODEL = 2048
BATCH = 16
SEQ = 256
DEPTH = 1
DEC_BATCH = 2
DEC_SEQ = 1024
PAST_LEN = 256

GRID_W = 64
HEAD_DIM = 128
A_HEADS = 8
A_KV_HEADS = 2
A_GROUP = A_HEADS // A_KV_HEADS
A_WINDOW = 128
BLOCK = 128
B_HEADS = 8
NA_ROWS_MAX = 8
NA_COLS = 16
D_FF = 4 * D_MODEL
ROPE_THETA = 10000.0
EPS = 1e-6
NEG = -1e30
Q_BLOCK = 128
A_Q = A_HEADS * HEAD_DIM
A_KV = A_KV_HEADS * HEAD_DIM
B_QKV = B_HEADS * HEAD_DIM
SPLIT_POINTS = (A_Q, A_Q + A_KV, A_Q + 2 * A_KV, A_Q + 2 * A_KV + B_QKV,
                A_Q + 2 * A_KV + 2 * B_QKV, A_Q + 2 * A_KV + 3 * B_QKV,
                A_Q + 2 * A_KV + 3 * B_QKV + D_MODEL)
IN_WIDTH = A_Q + 2 * A_KV + 3 * B_QKV + 2 * D_MODEL
SCALE = HEAD_DIM ** -0.5

kernel_name = "hybrid_dit_window_gqa_natten_prefix_step"


def rms_norm(x, w):
    xf = x.astype(jnp.float32)
    y = xf * lax.rsqrt(jnp.mean(xf * xf, axis=-1, keepdims=True) + EPS)
    return (y * w.astype(jnp.float32)).astype(x.dtype)


def ada_mod(cvec, w_ada, b_ada):
    m = jax.nn.silu(cvec) @ w_ada + b_ada
    return jnp.split(m, 6, axis=-1)


def softmax_sink(logits, sink_col):
    if sink_col is None:
        return jax.nn.softmax(logits, axis=-1)
    full = jnp.concatenate([logits, jnp.broadcast_to(sink_col, logits.shape[:-1] + (1,)).astype(jnp.float32)], axis=-1)
    return jax.nn.softmax(full, axis=-1)[..., :-1]


def axial_rope(x, T):
    n_freq = HEAD_DIM // 4
    pos = jnp.arange(T)
    row = (pos // GRID_W).astype(jnp.float32)
    col = (pos % GRID_W).astype(jnp.float32)
    inv = ROPE_THETA ** (-jnp.arange(n_freq, dtype=jnp.float32) / n_freq)
    shape = (T,) + (1,) * (x.ndim - 3) + (n_freq,)
    xf = x.astype(jnp.float32)
    xr, xc = jnp.split(xf, 2, axis=-1)

    def rot(xh, ang):
        cos = jnp.cos(ang).reshape(shape)
        sin = jnp.sin(ang).reshape(shape)
        x1, x2 = jnp.split(xh, 2, axis=-1)
        return jnp.concatenate([x1 * cos - x2 * sin, x1 * sin + x2 * cos], axis=-1)

    out = jnp.concatenate([rot(xr, row[:, None] * inv), rot(xc, col[:, None] * inv)], axis=-1)
    return out.astype(x.dtype)


def project_heads(h, w_in, q_norm_a, k_norm_a, q_norm_b, k_norm_b):
    B, T, _ = h.shape
    p = h @ w_in
    qa, ka, va, qb, kb, vb, ga, gb = jnp.split(p, SPLIT_POINTS, axis=-1)
    qa = rms_norm(qa.reshape(B, T, A_KV_HEADS, A_GROUP, HEAD_DIM), q_norm_a)
    ka = rms_norm(ka.reshape(B, T, A_KV_HEADS, HEAD_DIM), k_norm_a)
    va = va.reshape(B, T, A_KV_HEADS, HEAD_DIM)
    qb = rms_norm(qb.reshape(B, T, B_HEADS, HEAD_DIM), q_norm_b)
    kb = rms_norm(kb.reshape(B, T, B_HEADS, HEAD_DIM), k_norm_b)
    vb = vb.reshape(B, T, B_HEADS, HEAD_DIM)
    return qa, ka, va, qb, kb, vb, ga, gb


def merge_branches(oa, ob, ga, gb, w_br_a, w_br_b, w_out):
    B, T = oa.shape[:2]
    ya = oa.reshape(B, T, A_Q) @ w_br_a
    yb = ob.reshape(B, T, B_QKV) @ w_br_b
    return (jax.nn.sigmoid(ga) * ya + jax.nn.sigmoid(gb) * yb) @ w_out


def sq_relu_mlp(h, w_up, w_down):
    return jnp.square(jax.nn.relu(h @ w_up)) @ w_down


def context_attention(q, k, v, sink):
    B, S, Hk, G, D = q.shape
    nb = S // Q_BLOCK
    qb = jnp.moveaxis(q.reshape(B, nb, Q_BLOCK, Hk, G, D), 1, 0)
    sink_col = None if sink is None else sink[None, :, :, None, None]

    def one_block(qblk):
        lg = jnp.einsum("bqhgd,bkhd->bhgqk", qblk, k).astype(jnp.float32) * SCALE
        pr = softmax_sink(lg, sink_col)
        return jnp.einsum("bhgqk,bkhd->bqhgd", pr.astype(v.dtype), v)

    out = lax.map(one_block, qb)
    return jnp.moveaxis(out, 0, 1).reshape(B, S, Hk, G, D)


def latent_window_attention(q, k, v, kc, vc, sink):
    B, T, Hk, G, D = q.shape
    nb = T // BLOCK
    qb = q.reshape(B, nb, BLOCK, Hk, G, D)

    def band(t):
        tp = jnp.pad(t, ((0, 0), (BLOCK, BLOCK), (0, 0), (0, 0)))
        tb = tp.reshape(B, nb + 2, BLOCK, Hk, D)
        return jnp.concatenate([tb[:, :-2], tb[:, 1:-1], tb[:, 2:]], axis=2)

    kband, vband = band(k), band(v)
    qpos = jnp.arange(nb)[:, None] * BLOCK + jnp.arange(BLOCK)[None, :]
    kpos = (jnp.arange(nb)[:, None] - 1) * BLOCK + jnp.arange(3 * BLOCK)[None, :]
    valid = ((kpos[:, None, :] >= 0) & (kpos[:, None, :] < T)
             & (jnp.abs(qpos[:, :, None] - kpos[:, None, :]) <= A_WINDOW))
    lg_loc = jnp.einsum("bnqhgd,bnkhd->bnhgqk", qb, kband).astype(jnp.float32) * SCALE
    lg_loc = jnp.where(valid[None, :, None, None], lg_loc, NEG)
    lg_ctx = jnp.einsum("bnqhgd,bchd->bnhgqc", qb, kc).astype(jnp.float32) * SCALE
    pr = softmax_sink(jnp.concatenate([lg_loc, lg_ctx], axis=-1), sink[None, None, :, :, None, None])
    p_loc = pr[..., :3 * BLOCK].astype(v.dtype)
    p_ctx = pr[..., 3 * BLOCK:].astype(v.dtype)
    out = (jnp.einsum("bnhgqk,bnkhd->bnqhgd", p_loc, vband)
           + jnp.einsum("bnhgqc,bchd->bnqhgd", p_ctx, vc))
    return out.reshape(B, T, Hk, G, D)


def latent_neighbourhood_attention(q, k, v, kc, vc, rpb):
    B, T, H, D = q.shape
    rows = T // GRID_W
    kr = min(NA_ROWS_MAX, rows)
    r = jnp.arange(rows)
    col = jnp.arange(GRID_W)
    rstart = jnp.clip(r - kr // 2, 0, rows - kr)
    row_idx = rstart[:, None] + jnp.arange(kr)[None, :]
    cstart = jnp.clip(col - NA_COLS // 2, 0, GRID_W - NA_COLS)
    K = kr * GRID_W
    qg = q.reshape(B, rows, GRID_W, H, D)
    kg = k.reshape(B, rows, GRID_W, H, D)[:, row_idx].reshape(B, rows, K, H, D)
    vg = v.reshape(B, rows, GRID_W, H, D)[:, row_idx].reshape(B, rows, K, H, D)
    key_row = jnp.broadcast_to(row_idx[:, :, None], (rows, kr, GRID_W)).reshape(rows, K)
    key_col = jnp.tile(col, kr)
    valid = (key_col[None, :] >= cstart[:, None]) & (key_col[None, :] < cstart[:, None] + NA_COLS)
    dr = key_row[:, None, :] - r[:, None, None] + NA_ROWS_MAX - 1
    dc = jnp.clip(key_col[None, :] - col[:, None] + NA_COLS - 1, 0, 2 * NA_COLS - 2)
    bias = rpb[:, dr, dc].astype(jnp.float32)
    lg_loc = jnp.einsum("brwhd,brkhd->bhrwk", qg, kg).astype(jnp.float32) * SCALE + bias[None]
    lg_loc = jnp.where(valid[None, None, None], lg_loc, NEG)
    lg_ctx = jnp.einsum("brwhd,bchd->bhrwc", qg, kc).astype(jnp.float32) * SCALE
    pr = jax.nn.softmax(jnp.concatenate([lg_loc, lg_ctx], axis=-1), axis=-1)
    p_loc = pr[..., :K].astype(v.dtype)
    p_ctx = pr[..., K:].astype(v.dtype)
    out = (jnp.einsum("bhrwk,brkhd->brwhd", p_loc, vg)
           + jnp.einsum("bhrwc,bchd->brwhd", p_ctx, vc))
    return out.reshape(B, T, H, D)


def setup_inputs(seed: int = 0) -> dict:
    key = jax.random.key(seed)
    ks = jax.random.split(key, 24)
    f32 = jnp.float32

    def nrm(k, shape, scale):
        return jax.random.normal(k, shape, f32) * scale

    return {
        "x_prompt": nrm(ks[0], (BATCH, SEQ, D_MODEL), 1.0),
        "x_sample": nrm(ks[1], (DEC_BATCH, DEC_SEQ, D_MODEL), 1.0),
        "cache_a_k": nrm(ks[2], (DEC_BATCH, DEPTH, PAST_LEN, A_KV_HEADS, HEAD_DIM), 1.0),
        "cache_a_v": nrm(ks[3], (DEC_BATCH, DEPTH, PAST_LEN, A_KV_HEADS, HEAD_DIM), 1.0),
        "cache_b_k": nrm(ks[4], (DEC_BATCH, DEPTH, PAST_LEN, B_HEADS, HEAD_DIM), 1.0),
        "cache_b_v": nrm(ks[5], (DEC_BATCH, DEPTH, PAST_LEN, B_HEADS, HEAD_DIM), 1.0),
        "c": nrm(ks[6], (DEC_BATCH, D_MODEL), 1.0),
        "c_ctx": nrm(ks[7], (D_MODEL,), 1.0),
        "norm1_w": 1.0 + nrm(ks[8], (DEPTH, D_MODEL), 0.01),
        "norm2_w": 1.0 + nrm(ks[9], (DEPTH, D_MODEL), 0.01),
        "w_ada": nrm(ks[10], (DEPTH, D_MODEL, 6 * D_MODEL), D_MODEL ** -0.5),
        "b_ada": nrm(ks[11], (DEPTH, 6 * D_MODEL), 0.01),
        "w_in": nrm(ks[12], (DEPTH, D_MODEL, IN_WIDTH), D_MODEL ** -0.5),
        "q_norm_a": 1.0 + nrm(ks[13], (DEPTH, HEAD_DIM), 0.01),
        "k_norm_a": 1.0 + nrm(ks[14], (DEPTH, HEAD_DIM), 0.01),
        "q_norm_b": 1.0 + nrm(ks[15], (DEPTH, HEAD_DIM), 0.01),
        "k_norm_b": 1.0 + nrm(ks[16], (DEPTH, HEAD_DIM), 0.01),
        "sink_a": nrm(ks[17], (DEPTH, A_HEADS), 0.5),
        "rpb_b": nrm(ks[18], (DEPTH, B_HEADS, 2 * NA_ROWS_MAX - 1, 2 * NA_COLS - 1), 0.1),
        "w_br_a": nrm(ks[19], (DEPTH, A_Q, D_MODEL), A_Q ** -0.5),
        "w_br_b": nrm(ks[20], (DEPTH, B_QKV, D_MODEL), B_QKV ** -0.5),
        "w_out": nrm(ks[21], (DEPTH, D_MODEL, D_MODEL), D_MODEL ** -0.5),
        "w_up": nrm(ks[22], (DEPTH, D_MODEL, D_FF), D_MODEL ** -0.5),
        "w_down": nrm(ks[23], (DEPTH, D_FF, D_MODEL), D_FF ** -0.5),
    }


def reference(x_prompt, x_sample, cache_a_k, cache_a_v, cache_b_k, cache_b_v, c, c_ctx,
              norm1_w, norm2_w, w_ada, b_ada, w_in, q_norm_a, k_norm_a, q_norm_b, k_norm_b,
              sink_a, rpb_b, w_br_a, w_br_b, w_out, w_up, w_down):
    xp = x_prompt
    new_ak, new_av, new_bk, new_bv = [], [], [], []
    for l in range(DEPTH):
        sh1, sc1, g1, sh2, sc2, g2 = ada_mod(c_ctx[None, None, :], w_ada[l], b_ada[l])
        h = rms_norm(xp, norm1_w[l]) * (1 + sc1) + sh1
        qa, ka, va, qb, kb, vb, ga, gb = project_heads(h, w_in[l], q_norm_a[l], k_norm_a[l],
                                                        q_norm_b[l], k_norm_b[l])
        sink = sink_a[l].reshape(A_KV_HEADS, A_GROUP)
        oa = context_attention(qa, ka, va, sink)
        ob = context_attention(qb[:, :, :, None, :], kb, vb, None)
        xp = xp + g1 * merge_branches(oa, ob, ga, gb, w_br_a[l], w_br_b[l], w_out[l])
        h2 = rms_norm(xp, norm2_w[l]) * (1 + sc2) + sh2
        xp = xp + g2 * sq_relu_mlp(h2, w_up[l], w_down[l])
        new_ak.append(ka)
        new_av.append(va)
        new_bk.append(kb)
        new_bv.append(vb)
    y_prompt = xp
    new_a_k = jnp.stack(new_ak, axis=1)
    new_a_v = jnp.stack(new_av, axis=1)
    new_b_k = jnp.stack(new_bk, axis=1)
    new_b_v = jnp.stack(new_bv, axis=1)

    xs = x_sample
    T = xs.shape[1]
    for l in range(DEPTH):
        sh1, sc1, g1, sh2, sc2, g2 = ada_mod(c[:, None, :], w_ada[l], b_ada[l])
        h = rms_norm(xs, norm1_w[l]) * (1 + sc1) + sh1
        qa, ka, va, qb, kb, vb, ga, gb = project_heads(h, w_in[l], q_norm_a[l], k_norm_a[l],
                                                        q_norm_b[l], k_norm_b[l])
        qa = axial_rope(qa, T)
        ka = axial_rope(ka, T)
        sink = sink_a[l].reshape(A_KV_HEADS, A_GROUP)
        oa = latent_window_attention(qa, ka, va, cache_a_k[:, l], cache_a_v[:, l], sink)
        ob = latent_neighbourhood_attention(qb, kb, vb, cache_b_k[:, l], cache_b_v[:, l], rpb_b[l])
        xs = xs + g1 * merge_branches(oa, ob, ga, gb, w_br_a[l], w_br_b[l], w_out[l])
        h2 = rms_norm(xs, norm2_w[l]) * (1 + sc2) + sh2
        xs = xs + g2 * sq_relu_mlp(h2, w_up[l], w_down[l])
    y_sample = xs
    return (y_prompt, y_sample, new_a_k, new_a_v, new_b_k, new_b_v)
```

```cpp
#include <hip/hip_runtime.h>
#include <hip/hip_cooperative_groups.h>
#include <cstdio>
namespace cg = cooperative_groups;

typedef unsigned short bf16_t;
typedef short bf16x8 __attribute__((ext_vector_type(8)));
typedef short s16x4 __attribute__((ext_vector_type(4)));
typedef float f32x4 __attribute__((ext_vector_type(4)));
typedef float f32x16 __attribute__((ext_vector_type(16)));
typedef unsigned u32x4 __attribute__((ext_vector_type(4)));
typedef unsigned u32x2 __attribute__((ext_vector_type(2)));
typedef float f32x2 __attribute__((ext_vector_type(2)));
#define LAS __attribute__((address_space(3)))

constexpr int DM = 2048, NPROMPT = 4096, MTOK = 6144, INW = 8704, DFF = 8192, PW = 3328;
constexpr float LOG2E = 1.4426950408889634f;
constexpr float SM_SCALE = 0.088388347648318440f;
constexpr float NEGBIG = -1e30f;

constexpr size_t SZ_WIN = (size_t)INW * DM * 2, SZ_WBR = (size_t)DM * 1024 * 2, SZ_WOUT = (size_t)DM * DM * 2, SZ_WUP = (size_t)DFF * DM * 2;
constexpr size_t WS_WIN = 0;
constexpr size_t WS_WBRA = WS_WIN + SZ_WIN;
constexpr size_t WS_WBRB = WS_WBRA + SZ_WBR;
constexpr size_t WS_WOUT = WS_WBRB + SZ_WBR;
constexpr size_t WS_WUP = WS_WOUT + SZ_WOUT;
constexpr size_t WS_WDOWN = WS_WUP + SZ_WUP;
constexpr size_t WS_H = WS_WDOWN + SZ_WUP;
constexpr size_t WS_P = WS_H + (size_t)MTOK * DM * 2;
static_assert((size_t)MTOK * DM * 4 + (size_t)MTOK * DM * 2 <= (size_t)MTOK * PW * 4, "X1 + O fit the WS_P region");
constexpr size_t WS_QK = WS_P + (size_t)MTOK * PW * 4;
constexpr size_t WS_V = WS_QK + (size_t)MTOK * PW * 2;
constexpr size_t WS_G = WS_V + (size_t)MTOK * 1280 * 2;
constexpr size_t WS_M = WS_G + (size_t)MTOK * 4096 * 2;
constexpr size_t WS_CTX = WS_M + (size_t)MTOK * DM * 2;
constexpr size_t WS_MOD = WS_CTX + (size_t)2 * 256 * (256 * 2 + 1024 * 2) * 2;
constexpr size_t WS_ROPE = WS_MOD + (size_t)3 * 12288 * 4;
constexpr size_t WS_NORMW = WS_ROPE + 2 * 64 * 32 * 4;
constexpr size_t WS_BAR = WS_NORMW + 2048;
constexpr size_t WS_END = WS_BAR + 16384;
static_assert((size_t)MTOK * DFF * 2 <= WS_M - WS_QK, "U overlay");

constexpr int OUT_YP = 0, OUT_AK = 12582912, OUT_AV = 13631488, OUT_BK = 14680064, OUT_BV = 18874368;

constexpr int LDS_BYTES = 131072 + 8192 + 256;

struct Params {
    const float *x_prompt, *x_sample, *cak, *cav, *cbk, *cbv, *c, *c_ctx, *norm1_w, *norm2_w, *w_ada, *b_ada, *w_in,
        *qna, *kna, *qnb, *knb, *sink_a, *rpb, *w_br_a, *w_br_b, *w_out, *w_up, *w_down;
    float* out; char* ws; int ph_lo, ph_hi;
};

typedef __bf16 bf16x2_t __attribute__((ext_vector_type(2)));
__device__ __forceinline__ unsigned cvtpk(float lo, float hi) { f32x2 v = {lo, hi}; bf16x2_t b = __builtin_convertvector(v, bf16x2_t); return __builtin_bit_cast(unsigned, b); }
__device__ __forceinline__ bf16_t f2bf(float f) { return (bf16_t)(cvtpk(f, 0.f) & 0xffffu); }
__device__ __forceinline__ float wave_sum(float v) {
#pragma unroll
    for (int o = 32; o > 0; o >>= 1) v += __shfl_xor(v, o);
    return v;
}
__device__ __forceinline__ float sigmoidf_(float x) { return __builtin_amdgcn_rcpf(1.f + __expf(-x)); }

namespace pg8 {
constexpr int BM = 256, BK = 64, HALF = 128, HTB = HALF * BK * 2, STAGE_BYTES = 8 * HTB, NXCD = 8, WGM = 4;
__device__ __forceinline__ int lds_byte(int r, int c) { const int st = (r >> 4) * 2 + (c >> 5), rr = r & 15, cc = c & 31, ob = rr * 64 + cc * 2; return st * 1024 + (ob ^ (((ob >> 9) & 1) << 5)); }
__device__ __forceinline__ void stage_rc(int b, int& R, int& C) { const int st = b / 1024, sb = b % 1024, swz = sb ^ (((sb >> 9) & 1) << 5); R = (st >> 1) * 16 + swz / 64; C = (st & 1) * 32 + (swz % 64) / 2; }
__device__ __forceinline__ int perm32(int rho) { const int n = rho >> 4, i = rho & 15; return 8 * (i >> 2) + 4 * n + (i & 3); }
struct Unit { int pm, pn, part; };
struct Gemm { const bf16_t* A; const bf16_t* Bt; int M, N, K, ld; };
struct StaticOrder {
    int nM, nN, nwg, G, c, parts;
    __device__ void init(int M, int N, int G_, int c_, int parts_ = 1, int tile_rows = BM) { nM = M / tile_rows; nN = N / BM; nwg = nM * nN; G = G_; c = c_; parts = parts_; }
    __device__ bool next(int i, Unit& u) const {
        u.part = (parts == 2) ? (i & 1) : 0; if (parts == 2) i >>= 1;
        const long L = (long)i * G + c; if (L >= nwg) return false;
        int wgid = (int)L; { const int q = nwg / NXCD, r = nwg % NXCD, xcd = wgid % NXCD, off = wgid / NXCD; wgid = (xcd < r ? xcd * (q + 1) : r * (q + 1) + (xcd - r) * q) + off; }
        const int nig = WGM * nN, gid = wgid / nig, fm = gid * WGM, gsz = (nM - fm) < WGM ? (nM - fm) : WGM;
        u.pm = fm + ((wgid % nig) % gsz); u.pn = (wgid % nig) / gsz; return true;
    }
};

template <class Epi, bool TWOPART = false, bool T192 = false>
__device__ __forceinline__ void gemm_phase(LAS unsigned char* lds, const Gemm g, const StaticOrder& S, const Epi& E) {
    int tid_ = threadIdx.x; asm volatile("" : "+v"(tid_));
    const int tid = tid_, wid = __builtin_amdgcn_readfirstlane(tid >> 6), lane = tid & 63, wr = wid >> 2, wc = wid & 3, fr = lane & 15, fq = lane >> 4;
    const int K = g.K, nt = K / BK;
    constexpr int M1 = T192 ? 2 : 4;
    unsigned voffA[2], voffA1[2], voffB[2];
#pragma unroll
    for (int i = 0; i < 2; ++i) { int R, C; stage_rc(tid * 16 + i * 8192, R, C); const int Rb = (R & ~31) + perm32(R & 31);
        const int R1 = T192 ? ((R & 31) + 32 * ((R >> 6) & 1)) : R;
        voffA[i] = (unsigned)(R * g.ld + C) * 2u; voffA1[i] = (unsigned)(R1 * g.ld + C) * 2u; voffB[i] = (unsigned)(Rb * g.ld + C) * 2u; }
    const size_t kstep = (size_t)(BK * 2);
    const size_t hstep = (size_t)HALF * g.ld * 2;
    const size_t pstep = (size_t)K * 2;
    const size_t tstep = 2 * hstep;
    const size_t tstepA = T192 ? (size_t)192 * g.ld * 2 : tstep;
    const unsigned ldsw = (unsigned)wid * 1024u;
    const int aoff = lds_byte(wr * 64 + fr, fq * 8), boff = lds_byte(wc * 32 + fr, fq * 8);
#define PG8_SA(b, h) (((b) * 2 + (h)) * HTB)
#define PG8_SB(b, h) ((4 + (b) * 2 + (h)) * HTB)
#define PG8_STAGE(bufoff, gbase, voff) do { _Pragma("unroll") for (int _i = 0; _i < 2; ++_i) \
        __builtin_amdgcn_global_load_lds((const unsigned*)((const char*)(gbase) + (voff)[_i]), (LAS unsigned*)(lds + (bufoff) + ldsw + _i * 8192), 16, 0, 0); } while (0)
#define PG8_LDA(dst, b, h) do { _Pragma("unroll") for (int m = 0; m < ((h) ? M1 : 4); ++m) _Pragma("unroll") for (int k = 0; k < 2; ++k) dst[m][k] = *(const LAS bf16x8*)(lds + PG8_SA(b, h) + aoff + m * 2048 + k * 1024); } while (0)
#define PG8_LDB(dst, b, h) do { _Pragma("unroll") for (int n = 0; n < 2; ++n) _Pragma("unroll") for (int k = 0; k < 2; ++k) dst[n][k] = *(const LAS bf16x8*)(lds + PG8_SB(b, h) + boff + n * 2048 + k * 1024); } while (0)
#define PG8_MMA(ai, bj, At, Bt) do { __builtin_amdgcn_s_setprio(1); _Pragma("unroll") for (int m = 0; m < ((ai) ? M1 : 4); ++m) _Pragma("unroll") for (int n = 0; n < 2; ++n) _Pragma("unroll") for (int k = 0; k < 2; ++k) \
        acc[ai][bj][m][n] = __builtin_amdgcn_mfma_f32_16x16x32_bf16(Bt[n][k], At[m][k], acc[ai][bj][m][n], 0, 0, 0); __builtin_amdgcn_s_setprio(0); } while (0)
#define PG8_WAIT_V(n) asm volatile("s_waitcnt vmcnt(" #n ")" ::: "memory")
#define PG8_WAIT_L(n) asm volatile("s_waitcnt lgkmcnt(" #n ")" ::: "memory")
#define PG8_BAR __builtin_amdgcn_s_barrier()
#define PG8_SCHED __builtin_amdgcn_sched_barrier(0)
    Unit cur, nxt; int ui = 0;
    if (!S.next(0, cur)) return;
    f32x4 acc[2][2][4][2];
#pragma unroll
    for (int a = 0; a < 2; ++a)
#pragma unroll
        for (int b = 0; b < 2; ++b)
#pragma unroll
            for (int m = 0; m < 4; ++m)
#pragma unroll
                for (int n = 0; n < 2; ++n) acc[a][b][m][n] = (f32x4){0.f, 0.f, 0.f, 0.f};
    bf16x8 At[4][2], B0[2][2], B1[2][2];
    const char* cA = (const char*)g.A + (size_t)cur.pm * tstepA + cur.part * pstep; const char* cB = (const char*)g.Bt + (size_t)cur.pn * tstep + cur.part * pstep;
    PG8_STAGE(PG8_SB(0, 0), cB, voffB); PG8_STAGE(PG8_SA(0, 0), cA, voffA); PG8_STAGE(PG8_SB(0, 1), cB + hstep, voffB); PG8_STAGE(PG8_SA(0, 1), cA + hstep, voffA1);
    if (wr == 1) PG8_BAR;
    PG8_WAIT_V(4); PG8_BAR;
    PG8_STAGE(PG8_SB(1, 0), cB + kstep, voffB); PG8_STAGE(PG8_SA(1, 0), cA + kstep, voffA); PG8_STAGE(PG8_SB(1, 1), cB + hstep + kstep, voffB);
    PG8_WAIT_V(6); PG8_BAR;
    for (;;) {
        const bool has_next = S.next(ui + 1, nxt);
        const char* nA = has_next ? (const char*)g.A + (size_t)nxt.pm * tstepA + nxt.part * pstep : cA; const char* nB = has_next ? (const char*)g.Bt + (size_t)nxt.pn * tstep + nxt.part * pstep : cB;
        for (int t = 0; t < nt; t += 2) {
            const bool last = (t == nt - 2);
            const char* a1 = cA + (size_t)(t + 1) * kstep;
            const char* a2 = last ? nA : cA + (size_t)(t + 2) * kstep; const char* b2 = last ? nB : cB + (size_t)(t + 2) * kstep;
            const char* a3 = a2 + kstep; const char* b3 = b2 + kstep;
            PG8_LDB(B0, 0, 0); PG8_SCHED; PG8_LDA(At, 0, 0); PG8_STAGE(PG8_SA(1, 1), a1 + hstep, voffA1);
            PG8_WAIT_L(8); PG8_BAR; PG8_WAIT_L(0); PG8_MMA(0, 0, At, B0); PG8_BAR; PG8_SCHED;
            PG8_LDB(B1, 0, 1); PG8_STAGE(PG8_SB(0, 0), b2, voffB);
            PG8_BAR; PG8_WAIT_L(0); PG8_MMA(0, 1, At, B1); PG8_BAR;
            PG8_LDA(At, 0, 1); PG8_STAGE(PG8_SA(0, 0), a2, voffA);
            PG8_BAR; PG8_WAIT_L(0); PG8_MMA(1, 0, At, B0); PG8_BAR; PG8_SCHED;
            PG8_STAGE(PG8_SB(0, 1), b2 + hstep, voffB);
            PG8_WAIT_V(6); PG8_BAR; PG8_MMA(1, 1, At, B1); PG8_BAR;
            PG8_LDB(B0, 1, 0); PG8_SCHED; PG8_LDA(At, 1, 0); PG8_STAGE(PG8_SA(0, 1), a2 + hstep, voffA1);
            PG8_WAIT_L(8); PG8_BAR; PG8_WAIT_L(0); PG8_MMA(0, 0, At, B0); PG8_BAR; PG8_SCHED;
            PG8_LDB(B1, 1, 1); PG8_STAGE(PG8_SB(1, 0), b3, voffB);
            PG8_BAR; PG8_WAIT_L(0); PG8_MMA(0, 1, At, B1); PG8_BAR;
            PG8_LDA(At, 1, 1); PG8_STAGE(PG8_SA(1, 0), a3, voffA);
            PG8_BAR; PG8_WAIT_L(0); PG8_MMA(1, 0, At, B0); PG8_BAR; PG8_SCHED;
            PG8_STAGE(PG8_SB(1, 1), b3 + hstep, voffB);
            PG8_WAIT_V(6); PG8_BAR; PG8_MMA(1, 1, At, B1); PG8_BAR;
        }
        E(acc, cur, wr, wc, fr, fq);
        if (!has_next) break;
        if (!(TWOPART && cur.part == 0))
#pragma unroll
        for (int a = 0; a < 2; ++a)
#pragma unroll
            for (int b = 0; b < 2; ++b)
#pragma unroll
                for (int m = 0; m < 4; ++m)
#pragma unroll
                    for (int n = 0; n < 2; ++n) acc[a][b][m][n] = (f32x4){0.f, 0.f, 0.f, 0.f};
        cur = nxt; cA = nA; cB = nB; ++ui;
    }
    PG8_WAIT_V(0);
    if (wr == 0) PG8_BAR;
    PG8_BAR;
#undef PG8_SA
#undef PG8_SB
#undef PG8_STAGE
#undef PG8_LDA
#undef PG8_LDB
#undef PG8_MMA
#undef PG8_WAIT_V
#undef PG8_WAIT_L
#undef PG8_BAR
#undef PG8_SCHED
}
}
using pg8::Unit;
typedef f32x4 AccT[2][2][4][2];

__device__ __forceinline__ u32x4 pack8(f32x4 a, f32x4 b) { return (u32x4){cvtpk(a[0], a[1]), cvtpk(a[2], a[3]), cvtpk(b[0], b[1]), cvtpk(b[2], b[3])}; }
__device__ __forceinline__ void unpack8(u32x4 w, f32x4& a, f32x4& b) {
    a = (f32x4){__uint_as_float(w[0] << 16), __uint_as_float(w[0] & 0xffff0000u), __uint_as_float(w[1] << 16), __uint_as_float(w[1] & 0xffff0000u)};
    b = (f32x4){__uint_as_float(w[2] << 16), __uint_as_float(w[2] & 0xffff0000u), __uint_as_float(w[3] << 16), __uint_as_float(w[3] & 0xffff0000u)};
}

struct Epi1 {
    char* ws; float* out; float* red;
    __device__ __forceinline__ void operator()(const AccT& acc, const Unit& u, int wr, int wc, int fr, int fq) const {
        const int pn = u.pn, row0 = u.pm * 256 + wr * 64 + fr, cin = wc * 32 + 8 * fq;
        bf16_t* QA = (bf16_t*)(ws + WS_QK); bf16_t* KA = QA + (size_t)MTOK * 1024; bf16_t* QB = KA + (size_t)MTOK * 256; bf16_t* KB = QB + (size_t)MTOK * 1024;
        bf16_t* VA = (bf16_t*)(ws + WS_V); bf16_t* VB = VA + (size_t)MTOK * 256; bf16_t* G = (bf16_t*)(ws + WS_G);
        float* out_ak = out + OUT_AK; float* out_bk = out + OUT_BK; float* out_av = out + OUT_AV; float* out_bv = out + OUT_BV;
        if (pn < 5 || (pn >= 6 && pn < 14)) {
#pragma unroll
            for (int ai = 0; ai < 2; ++ai)
#pragma unroll
                for (int m = 0; m < 4; ++m)
#pragma unroll
                    for (int bj = 0; bj < 2; ++bj) { const f32x4 a = acc[ai][bj][m][0], b = acc[ai][bj][m][1];
                        float s = a[0] * a[0] + a[1] * a[1] + a[2] * a[2] + a[3] * a[3] + b[0] * b[0] + b[1] * b[1] + b[2] * b[2] + b[3] * b[3];
                        s += __shfl_xor(s, 16); s += __shfl_xor(s, 32);
                        if (fq == 0) red[((((wr * 8 + ai * 4 + m) * 16 + fr) * 2 + bj) * 4) + wc] = s; }
            asm volatile("s_waitcnt lgkmcnt(0)" ::: "memory"); __builtin_amdgcn_s_barrier(); asm volatile("" ::: "memory");
            const bool isK = (pn == 4 || pn >= 10), brA = (pn < 5);
            const float* nwp = (const float*)(ws + WS_NORMW) + ((brA ? 0 : 256) + (isK ? 128 : 0));
            const f32x4 w0 = *(const f32x4*)(nwp + cin), w1 = *(const f32x4*)(nwp + cin + 4);
            bf16_t* db = brA ? (isK ? KA : QA) : (isK ? KB : QB); const int ld = (brA && isK) ? 256 : 1024;
            const int dcol = (pn < 4 ? pn * 256 : pn == 4 ? 0 : pn < 10 ? (pn - 6) * 256 : (pn - 10) * 256) + cin;
            float* ob = brA ? out_ak : out_bk; const bool wout = isK && (u.pm < 16);
#pragma unroll
            for (int ai = 0; ai < 2; ++ai)
#pragma unroll
                for (int m = 0; m < 4; ++m) { const size_t ro = (size_t)(row0 + ai * 128 + m * 16) * ld + dcol;
#pragma unroll
                    for (int bj = 0; bj < 2; ++bj) {
                        const f32x4 pr = *(const f32x4*)(red + ((((wr * 8 + ai * 4 + m) * 16 + fr) * 2 + bj) * 4));
                        const float rstd = rsqrtf((pr[0] + pr[1] + pr[2] + pr[3]) * (1.f / 128.f) + 1e-6f);
                        const f32x4 v0 = acc[ai][bj][m][0] * rstd * w0, v1 = acc[ai][bj][m][1] * rstd * w1;
                        *(u32x4*)(db + ro + bj * 128) = pack8(v0, v1);
                        if (wout) { *(f32x4*)(ob + ro + bj * 128) = v0; *(f32x4*)(ob + ro + bj * 128 + 4) = v1; } } }
        } else if (pn < 18) {
            const bool isA = (pn == 5); const int ld = isA ? 256 : 1024; const int vcol = (isA ? 0 : (pn - 14) * 256) + cin;
            bf16_t* vb = isA ? VA : VB; float* ob = isA ? out_av : out_bv; const bool wout = (u.pm < 16);
#pragma unroll
            for (int ai = 0; ai < 2; ++ai)
#pragma unroll
                for (int m = 0; m < 4; ++m) { const size_t ro = (size_t)(row0 + ai * 128 + m * 16) * ld + vcol;
#pragma unroll
                    for (int bj = 0; bj < 2; ++bj) { *(u32x4*)(vb + ro + bj * 128) = pack8(acc[ai][bj][m][0], acc[ai][bj][m][1]);
                        if (wout) { *(f32x4*)(ob + ro + bj * 128) = acc[ai][bj][m][0]; *(f32x4*)(ob + ro + bj * 128 + 4) = acc[ai][bj][m][1]; } } }
        } else {
            const int gcol = (pn - 18) * 256 + cin;
#pragma unroll
            for (int ai = 0; ai < 2; ++ai)
#pragma unroll
                for (int m = 0; m < 4; ++m) { bf16_t* rp = G + (size_t)(row0 + ai * 128 + m * 16) * 4096 + gcol;
#pragma unroll
                    for (int bj = 0; bj < 2; ++bj) { f32x4 a = acc[ai][bj][m][0], b = acc[ai][bj][m][1];
#pragma unroll
                        for (int j = 0; j < 4; ++j) { a[j] = sigmoidf_(a[j]); b[j] = sigmoidf_(b[j]); }
                        *(u32x4*)(rp + bj * 128) = pack8(a, b); } }
        }
    }
};
struct EpiGate {
    bf16_t* G;
    __device__ __forceinline__ void operator()(const AccT& acc, const Unit& u, int wr, int wc, int fr, int fq) const {
        const int row0 = u.pm * 256 + wr * 64 + fr, gcol = u.pn * 256 + wc * 32 + 8 * fq;
#pragma unroll
        for (int ai = 0; ai < 2; ++ai)
#pragma unroll
            for (int m = 0; m < 4; ++m) { bf16_t* rp = G + (size_t)(row0 + ai * 128 + m * 16) * 4096 + gcol;
#pragma unroll
                for (int bj = 0; bj < 2; ++bj) { f32x4 a = acc[ai][bj][m][0], b = acc[ai][bj][m][1];
#pragma unroll
                    for (int j = 0; j < 4; ++j) { a[j] = sigmoidf_(a[j]); b[j] = sigmoidf_(b[j]); }
                    *(u32x4*)(rp + bj * 128) = pack8(a, b); } }
    }
};
template <bool T192> __device__ __forceinline__ int tile_row(int pm, int wr, int fr, int ai, int m) {
    return T192 ? pm * 192 + (ai ? 128 + 32 * wr : 64 * wr) + 16 * m + fr : pm * 256 + 128 * ai + 64 * wr + 16 * m + fr;
}
template <bool T192> struct EpiMerge {
    const bf16_t* G; bf16_t* Mo;
    __device__ __forceinline__ void operator()(AccT& acc, const Unit& u, int wr, int wc, int fr, int fq) const {
        const int col0 = u.pn * 256 + wc * 32 + 8 * fq;
        if (u.part == 0) {
#pragma unroll
            for (int ai = 0; ai < 2; ++ai)
#pragma unroll
                for (int m = 0; m < ((ai && T192) ? 2 : 4); ++m) { const size_t r = (size_t)tile_row<T192>(u.pm, wr, fr, ai, m);
#pragma unroll
                    for (int bj = 0; bj < 2; ++bj) { const int c = col0 + bj * 128; f32x4 a0, a1, b0, b1;
                        unpack8(*(const u32x4*)(G + r * 4096 + c), a0, a1); unpack8(*(const u32x4*)(G + r * 4096 + 2048 + c), b0, b1);
#pragma unroll
                        for (int j = 0; j < 4; ++j) { acc[ai][bj][m][0][j] *= a0[j] * __builtin_amdgcn_rcpf(fmaxf(b0[j], 1e-30f)); acc[ai][bj][m][1][j] *= a1[j] * __builtin_amdgcn_rcpf(fmaxf(b1[j], 1e-30f)); } } }
            return;
        }
#pragma unroll
        for (int ai = 0; ai < 2; ++ai)
#pragma unroll
            for (int m = 0; m < ((ai && T192) ? 2 : 4); ++m) { const size_t r = (size_t)tile_row<T192>(u.pm, wr, fr, ai, m);
#pragma unroll
                for (int bj = 0; bj < 2; ++bj) { const int c = col0 + bj * 128; f32x4 b0, b1; unpack8(*(const u32x4*)(G + r * 4096 + 2048 + c), b0, b1);
                    *(u32x4*)(Mo + r * DM + c) = pack8(acc[ai][bj][m][0] * b0, acc[ai][bj][m][1] * b1); } }
    }
};
template <bool T192, bool XBF = false, bool OBF = false> struct EpiRes {
    const void* Xp; const void* Xs; const float* mod; int goff; void* O;
    __device__ __forceinline__ void operator()(const AccT& acc, const Unit& u, int wr, int wc, int fr, int fq) const {
        const int col0 = u.pn * 256 + wc * 32 + 8 * fq;
#pragma unroll
        for (int ai = 0; ai < 2; ++ai)
#pragma unroll
            for (int m = 0; m < ((ai && T192) ? 2 : 4); ++m) { const int ri = tile_row<T192>(u.pm, wr, fr, ai, m); const size_t r = (size_t)ri;
                const int v = ri < NPROMPT ? 0 : 1 + ((ri - NPROMPT) >> 10);
                const size_t xo = ri < NPROMPT ? r * DM : (r - NPROMPT) * DM; const void* Xb = ri < NPROMPT ? Xp : Xs;
                const float* gp = mod + v * 12288 + goff;
#pragma unroll
                for (int bj = 0; bj < 2; ++bj) { const int c = col0 + bj * 128;
                    const f32x4 g0 = *(const f32x4*)(gp + c), g1 = *(const f32x4*)(gp + c + 4);
                    f32x4 x0, x1;
                    if (XBF) unpack8(*(const u32x4*)((const bf16_t*)Xb + xo + c), x0, x1);
                    else { x0 = *(const f32x4*)((const float*)Xb + xo + c); x1 = *(const f32x4*)((const float*)Xb + xo + c + 4); }
                    const f32x4 o0 = x0 + g0 * acc[ai][bj][m][0], o1 = x1 + g1 * acc[ai][bj][m][1];
                    if (OBF) *(u32x4*)((bf16_t*)O + r * DM + c) = pack8(o0, o1);
                    else { *(f32x4*)((float*)O + r * DM + c) = o0; *(f32x4*)((float*)O + r * DM + c + 4) = o1; } } }
    }
};
struct EpiUp {
    bf16_t* U;
    __device__ __forceinline__ void operator()(const AccT& acc, const Unit& u, int wr, int wc, int fr, int fq) const {
        const int row0 = u.pm * 256 + wr * 64 + fr, col0 = u.pn * 256 + wc * 32 + 8 * fq;
#pragma unroll
        for (int ai = 0; ai < 2; ++ai)
#pragma unroll
            for (int m = 0; m < 4; ++m) { const size_t r = (size_t)(row0 + ai * 128 + m * 16);
#pragma unroll
                for (int bj = 0; bj < 2; ++bj) { f32x4 a = acc[ai][bj][m][0], b = acc[ai][bj][m][1];
#pragma unroll
                    for (int j = 0; j < 4; ++j) { a[j] = fmaxf(a[j], 0.f); a[j] *= a[j]; b[j] = fmaxf(b[j], 0.f); b[j] *= b[j]; }
                    *(u32x4*)(U + r * DFF + col0 + bj * 128) = pack8(a, b); } }
    }
};

constexpr int SHM_V = 64 * 128 * 2, SHM_K = 64 * 128 * 2;
constexpr int ATT_WS_OFF = 2 * SHM_V + 2 * SHM_K, ATT_TBL_OFF = ATT_WS_OFF + 8 * 64 * 4, TBL_PAD = 64;
constexpr float THR2 = 8.f * LOG2E;
#define KSWZ(row, colB) ((row) * 256 + ((colB) ^ (((row) & 7) << 4)))
#define SBAR() __builtin_amdgcn_sched_barrier(0)
__device__ __forceinline__ int crow(int r, int hi) { return (r & 3) + 8 * (r >> 2) + 4 * hi; }

struct MaskCtx { int mode, nctx, loc0, qw0, r32, hi; const float* tbl; };

__device__ __forceinline__ void xform(f32x16& p0, f32x16& p1, const MaskCtx& mc, int j) {
    constexpr float C = SM_SCALE * LOG2E;
    if (j >= mc.nctx && mc.mode != 0) {
        const int kpos0 = mc.loc0 + (j - mc.nctx) * 64;
        if (mc.mode == 1) {
            const bool need = (kpos0 + 63 - mc.qw0 > 128) || (mc.qw0 + 31 - kpos0 > 128);
            if (need) {
                const int d0 = kpos0 - (mc.qw0 + mc.r32) + 128 + 4 * mc.hi;
#pragma unroll
                for (int r = 0; r < 16; ++r) { const int kc = (r & 3) + 8 * (r >> 2);
                    p0[r] = ((unsigned)(d0 + kc) <= 256u) ? p0[r] * C : NEGBIG;
                    p1[r] = ((unsigned)(d0 + 32 + kc) <= 256u) ? p1[r] * C : NEGBIG; }
                return;
            }
        } else {
            const int rk = kpos0 >> 6, rq = mc.qw0 >> 6; const int rstart = min(max(rq - 4, 0), 8);
            if ((unsigned)(rk - rstart) >= 8u) {
#pragma unroll
                for (int r = 0; r < 16; ++r) { p0[r] = NEGBIG; p1[r] = NEGBIG; }
                return;
            }
            const int cq = (mc.qw0 & 63) + mc.r32; const int cstart = min(max(cq - 8, 0), 48);
            const int e0 = 4 * mc.hi - cstart;
            const float* tb = mc.tbl + (TBL_PAD + (rk - rq + 7) * 31 - cq + 15 + 4 * mc.hi);
#pragma unroll
            for (int r = 0; r < 16; ++r) { const int kc = (r & 3) + 8 * (r >> 2);
                const float b0 = tb[kc], b1 = tb[kc + 32];
                p0[r] = ((unsigned)(e0 + kc) < 16u) ? fmaf(p0[r], C, b0) : NEGBIG;
                p1[r] = ((unsigned)(e0 + 32 + kc) < 16u) ? fmaf(p1[r], C, b1) : NEGBIG; }
            return;
        }
    }
#pragma unroll
    for (int r = 0; r < 16; ++r) { p0[r] *= C; p1[r] *= C; }
}
__device__ __forceinline__ void partialSM(f32x16& p0, f32x16& p1, float& m_reg, float& mn, float& alpha, const MaskCtx& mc, int j) {
    xform(p0, p1, mc, j);
    float pmax = p0[0];
#pragma unroll
    for (int r = 1; r < 16; ++r) pmax = fmaxf(pmax, p0[r]);
#pragma unroll
    for (int r = 0; r < 16; ++r) pmax = fmaxf(pmax, p1[r]);
    { auto rr = __builtin_amdgcn_permlane32_swap(__float_as_uint(pmax), __float_as_uint(pmax), false, false);
      pmax = fmaxf(__uint_as_float(rr[0]), __uint_as_float(rr[1])); }
    if (__builtin_expect(__all(pmax - m_reg <= THR2), 1)) { mn = m_reg; alpha = 1.f; }
    else { mn = fmaxf(m_reg, pmax); alpha = __builtin_amdgcn_exp2f(m_reg - mn); m_reg = mn; }
#pragma unroll
    for (int r = 0; r < 16; ++r) { p0[r] -= mn; p1[r] -= mn; }
#pragma unroll
    for (int r = 0; r < 16; ++r) p0[r] = __builtin_amdgcn_exp2f(p0[r]);
}
__device__ __forceinline__ void finishSM(f32x16& p0, f32x16& p1, float alpha, float& l_reg, bf16x8& pa0, bf16x8& pa1, bf16x8& pa2, bf16x8& pa3) {
#pragma unroll
    for (int r = 0; r < 16; ++r) p1[r] = __builtin_amdgcn_exp2f(p1[r]);
    float ps = 0;
#pragma unroll
    for (int r = 0; r < 16; ++r) ps += p0[r];
#pragma unroll
    for (int r = 0; r < 16; ++r) ps += p1[r];
    { auto rr = __builtin_amdgcn_permlane32_swap(__float_as_uint(ps), __float_as_uint(ps), false, false);
      ps = __uint_as_float(rr[0]) + __uint_as_float(rr[1]); }
    l_reg = l_reg * alpha + ps;
#define PK4(P, BASE, OUT) do { unsigned a0 = cvtpk(P[BASE + 0], P[BASE + 1]), a1 = cvtpk(P[BASE + 2], P[BASE + 3]);   \
    unsigned b0 = cvtpk(P[BASE + 4], P[BASE + 5]), b1 = cvtpk(P[BASE + 6], P[BASE + 7]);                              \
    auto r0 = __builtin_amdgcn_permlane32_swap(a0, b0, false, false); auto r1 = __builtin_amdgcn_permlane32_swap(a1, b1, false, false); \
    u32x4 w = {r0[0], r1[0], r0[1], r1[1]}; OUT = *reinterpret_cast<bf16x8*>(&w); } while (0)
    PK4(p0, 0, pa0); PK4(p0, 8, pa1); PK4(p1, 0, pa2); PK4(p1, 8, pa3);
#undef PK4
}
__device__ __forceinline__ void qkt(f32x16& p0, f32x16& p1, const char* Ks, const bf16x8* qr, int r32, int hi) {
    p0 = f32x16{}; p1 = f32x16{};
#pragma unroll
    for (int d0 = 0; d0 < 8; ++d0) { const int cb = (d0 * 16 + hi * 8) * 2;
        bf16x8 b0 = *reinterpret_cast<const bf16x8*>(Ks + KSWZ(r32, cb));
        bf16x8 b1 = *reinterpret_cast<const bf16x8*>(Ks + KSWZ(32 + r32, cb));
        p0 = __builtin_amdgcn_mfma_f32_32x32x16_bf16(b0, qr[d0], p0, 0, 0, 0);
        p1 = __builtin_amdgcn_mfma_f32_32x32x16_bf16(b1, qr[d0], p1, 0, 0, 0); }
}
__device__ __forceinline__ int v_st(int k, int c) { const int kk = (k & ~0xC) | ((k & 4) << 1) | ((k & 8) >> 1); return ((kk >> 3) * 4 + (c >> 5)) * 512 + ((kk & 7) * 32 + (c & 31)) * 2; }
__device__ __forceinline__ int v_rd_base(int lane) { return ((lane & 3) << 3) | (((lane >> 2) & 3) << 6) | (((lane >> 4) & 1) << 5) | (((lane >> 5) & 1) << 8); }
constexpr int v_rd_off(int d0, int ks, int half) { return d0 * 512 + ks * 4096 + half * 2048; }
template <int OFF> __device__ __forceinline__ s16x4 tr_read(int vb) {
    s16x4 r; asm volatile("ds_read_b64_tr_b16 %0, %1 offset:%2" : "=&v"(r) : "v"(vb), "i"(OFF) : "memory"); return r;
}
template <int D0> __device__ __forceinline__ void pv_one(f32x16& od, int vb, bf16x8 pa0, bf16x8 pa1, bf16x8 pa2, bf16x8 pa3) {
    const s16x4 l0 = tr_read<v_rd_off(D0, 0, 0)>(vb), h0 = tr_read<v_rd_off(D0, 0, 1)>(vb), l1 = tr_read<v_rd_off(D0, 1, 0)>(vb), h1 = tr_read<v_rd_off(D0, 1, 1)>(vb);
    const s16x4 l2 = tr_read<v_rd_off(D0, 2, 0)>(vb), h2 = tr_read<v_rd_off(D0, 2, 1)>(vb), l3 = tr_read<v_rd_off(D0, 3, 0)>(vb), h3 = tr_read<v_rd_off(D0, 3, 1)>(vb);
    asm volatile("s_waitcnt lgkmcnt(0)" ::: "memory"); SBAR();
#define PK(L, H) (bf16x8){L[0], L[1], L[2], L[3], H[0], H[1], H[2], H[3]}
    od = __builtin_amdgcn_mfma_f32_32x32x16_bf16(pa0, PK(l0, h0), od, 0, 0, 0);
    od = __builtin_amdgcn_mfma_f32_32x32x16_bf16(pa1, PK(l1, h1), od, 0, 0, 0);
    od = __builtin_amdgcn_mfma_f32_32x32x16_bf16(pa2, PK(l2, h2), od, 0, 0, 0);
    od = __builtin_amdgcn_mfma_f32_32x32x16_bf16(pa3, PK(l3, h3), od, 0, 0, 0);
#undef PK
}
__device__ __forceinline__ void pv_d0(f32x16* o, int vb, bf16x8 pa0, bf16x8 pa1, bf16x8 pa2, bf16x8 pa3) {
    pv_one<0>(o[0], vb, pa0, pa1, pa2, pa3); pv_one<1>(o[1], vb, pa0, pa1, pa2, pa3); pv_one<2>(o[2], vb, pa0, pa1, pa2, pa3); pv_one<3>(o[3], vb, pa0, pa1, pa2, pa3);
}

__device__ __forceinline__ void attn_item(const bf16_t* Qb, const bf16_t* Kl, const bf16_t* Vl, const bf16_t* Kc, const bf16_t* Vc, bf16_t* Ob,
                                          int LDK, int nctx, int loc0, int NT, int mode, int qbase, bool has_sink, float sink2, const float* rpb_h, char* lds) {
    int tid_ = threadIdx.x; asm volatile("" : "+v"(tid_));
    const int tid = tid_, wid = tid >> 6, lane = tid & 63, r32 = lane & 31, hi = lane >> 5;
    char* V_lds = lds; char* K_lds = lds + 2 * SHM_V;
    float* wsf = (float*)(lds + ATT_WS_OFF) + wid * 64; float* li_l = wsf; float* al_l = wsf + 32;
    float* tbl = (float*)(lds + ATT_TBL_OFF);
    __syncthreads();
    if (mode == 2) { for (int e = tid; e < 465; e += 512) tbl[TBL_PAD + e] = rpb_h[e] * LOG2E; }
    MaskCtx mc; mc.mode = mode; mc.nctx = nctx; mc.loc0 = loc0; mc.qw0 = qbase + wid * 32; mc.r32 = r32; mc.hi = hi; mc.tbl = tbl;
    float m_reg = -1e30f, l_reg = 0; f32x16 o[4] = {}; bf16x8 qr[8];
    const bf16_t* Qw = Qb + (size_t)(wid * 32 + r32) * 1024 + hi * 8;
#pragma unroll
    for (int d0 = 0; d0 < 8; ++d0) qr[d0] = *reinterpret_cast<const bf16x8*>(Qw + d0 * 16);
    const int sr = tid >> 4, sc = (tid & 15) * 8, vst0 = v_st(sr, sc), vst1 = v_st(32 + sr, sc);
    const int off0 = sr * LDK + sc, off1 = (32 + sr) * LDK + sc;
    const int vb0 = (int)(uintptr_t)(LAS char*)V_lds + v_rd_base(lane);
    bf16x8 sv0, sv1, sk0, sk1;
#define TILEK(j) ((j) < nctx ? Kc + (size_t)(j) * 64 * LDK : Kl + (size_t)(loc0 + ((j) - nctx) * 64) * LDK)
#define TILEV(j) ((j) < nctx ? Vc + (size_t)(j) * 64 * LDK : Vl + (size_t)(loc0 + ((j) - nctx) * 64) * LDK)
#define SLOAD(j) do { const bf16_t* _k = TILEK(j); const bf16_t* _v = TILEV(j); \
    sv0 = *reinterpret_cast<const bf16x8*>(_v + off0); sv1 = *reinterpret_cast<const bf16x8*>(_v + off1); \
    sk0 = *reinterpret_cast<const bf16x8*>(_k + off0); sk1 = *reinterpret_cast<const bf16x8*>(_k + off1); } while (0)
#define SWRITE(b) do { *(bf16x8*)(V_lds + (b) * SHM_V + vst0) = sv0; *(bf16x8*)(V_lds + (b) * SHM_V + vst1) = sv1; const int kc_ = sc * 2; \
    *(bf16x8*)(K_lds + (b) * SHM_K + KSWZ(sr, kc_)) = sk0; *(bf16x8*)(K_lds + (b) * SHM_K + KSWZ(32 + sr, kc_)) = sk1; } while (0)
#define RESC(a) do { if (__any((a) < 1.f)) { if (hi == 0) al_l[r32] = (a); asm volatile("s_waitcnt lgkmcnt(0)" ::: "memory"); \
    _Pragma("unroll") for (int d = 0; d < 4; ++d) _Pragma("unroll") for (int r = 0; r < 16; ++r) o[d][r] *= al_l[crow(r, hi)]; } } while (0)
    SLOAD(0); SWRITE(0); if (NT > 1) SLOAD(1);
    __syncthreads();
    for (int j = 0; j < NT; ++j) {
        const int bo = j & 1;
        if (j + 1 < NT) { SWRITE(bo ^ 1); if (j + 2 < NT) SLOAD(j + 2); }
        f32x16 p0, p1; float mn, al; bf16x8 pa0, pa1, pa2, pa3;
        SBAR(); qkt(p0, p1, K_lds + bo * SHM_K, qr, r32, hi);
        partialSM(p0, p1, m_reg, mn, al, mc, j);
        RESC(al);
        finishSM(p0, p1, al, l_reg, pa0, pa1, pa2, pa3); SBAR();
        pv_d0(o, vb0 + bo * SHM_V, pa0, pa1, pa2, pa3);
        __syncthreads();
    }
    if (has_sink) l_reg += __builtin_amdgcn_exp2f(sink2 - m_reg);
    if (hi == 0) li_l[r32] = l_reg; asm volatile("s_waitcnt lgkmcnt(0)" ::: "memory");
    float rli[16];
#pragma unroll
    for (int r = 0; r < 16; ++r) rli[r] = __builtin_amdgcn_rcpf(li_l[crow(r, hi)]);
    bf16_t* Ow = Ob + (size_t)(wid * 32) * 2048;
#pragma unroll
    for (int r = 0; r < 16; ++r) { const int orow = crow(r, hi);
#pragma unroll
        for (int d0 = 0; d0 < 4; ++d0) Ow[(size_t)orow * 2048 + d0 * 32 + r32] = f2bf(o[d0][r] * rli[r]); }
#undef TILEK
#undef TILEV
#undef SLOAD
#undef SWRITE
#undef RESC
}


__device__ __forceinline__ void transpose_item(const Params& p, int t, int tid, char* shm) {
    char* ws = p.ws; const float* W; bf16_t* WT; int N, ldk, koff = 0;
    if (t < 4352) { W = p.w_in; WT = (bf16_t*)(ws + WS_WIN); ldk = 2048; N = INW; }
    else if (t < 4864) { t -= 4352; W = p.w_br_a; WT = (bf16_t*)(ws + WS_WBRA); ldk = 2048; N = 2048; }
    else if (t < 5376) { t -= 4864; W = p.w_br_b; WT = (bf16_t*)(ws + WS_WBRA); ldk = 2048; N = 2048; koff = 1024; }
    else if (t < 6400) { t -= 5376; W = p.w_out; WT = (bf16_t*)(ws + WS_WOUT); ldk = 2048; N = 2048; }
    else if (t < 10496) { t -= 6400; W = p.w_up; WT = (bf16_t*)(ws + WS_WUP); ldk = 2048; N = DFF; }
    else { t -= 10496; W = p.w_down; WT = (bf16_t*)(ws + WS_WDOWN); ldk = DFF; N = 2048; }
    const int nN = N >> 6; const int tn = t % nN, tk = t / nN; const int k0 = tk * 64, n0 = tn * 64;
    bf16_t* T = (bf16_t*)shm;
    const int kq = tid >> 6, c4 = tid & 63;
    f32x4 v[8];
#pragma unroll
    for (int i = 0; i < 8; ++i) v[i] = __builtin_nontemporal_load((const f32x4*)(W + (size_t)(k0 + 8 * kq + i) * N + n0 + c4 * 4));
#pragma unroll
    for (int j = 0; j < 4; ++j) {
        const u32x4 w = {cvtpk(v[0][j], v[1][j]), cvtpk(v[2][j], v[3][j]), cvtpk(v[4][j], v[5][j]), cvtpk(v[6][j], v[7][j])};
        *(u32x4*)(T + (j * 64 + c4) * 72 + kq * 8) = w; }
    __syncthreads();
#pragma unroll
    for (int q = 0; q < 4; ++q) { const int n = (tid >> 3) + 64 * q, kc = tid & 7;
        *(u32x4*)(WT + (size_t)(n0 + n) * ldk + koff + k0 + kc * 8) = *(const u32x4*)(T + ((n & 3) * 64 + (n >> 2)) * 72 + kc * 8); }
    __syncthreads();
}

#ifndef DUP_PHASE
#define DUP_PHASE -1
#endif
#define REP(n) for (int rep_ = 0; rep_ < ((n) == DUP_PHASE ? 2 : 1); ++rep_)
#define W_DOWN_PART(h) do { const int nt_ = (MTOK / 256) * (DM / 256); int tid_ = threadIdx.x; asm volatile("" : "+v"(tid_)); \
    (void)nt_; for (int it = blockIdx.x; it < 512; it += gridDim.x) transpose_item(p, 10496 + ((h) * 512 + it) * 4, tid_, shm); } while (0)
#define PHASE_ON(n) (p.ph_lo <= (n) && (n) <= p.ph_hi)
#define XB_TMO      128
#define XB_XCNT(j)  (256  + 64 * (j))
#define XB_XSUB(j)  (1280 + 64 * (j))
#define XB_XGEN(j)  (2304 + 64 * (j))
#define XB_TOP      3328
#define XB_TOPGEN   3392
#define XCD_BAR_WORDS 3456
#define XB_SPIN_CAP (1u << 20)
__device__ __forceinline__ unsigned xb_ld(unsigned* q)              { return __hip_atomic_load(q, __ATOMIC_RELAXED, __HIP_MEMORY_SCOPE_AGENT); }
__device__ __forceinline__ unsigned xb_add(unsigned* q, unsigned v) { return __hip_atomic_fetch_add(q, v, __ATOMIC_RELAXED, __HIP_MEMORY_SCOPE_AGENT); }
__device__ __forceinline__ unsigned xb_xcc_id() { return (unsigned)__builtin_amdgcn_s_getreg((3 << 11) | 20) & 0xFu; }
#define XB_SPIN(cond, bar) do { unsigned _sp = 0; while (cond) { __builtin_amdgcn_s_sleep(1); \
    if ((++_sp & 255u) == 0u) { if (xb_ld(&(bar)[XB_TMO])) break; if (_sp > XB_SPIN_CAP) { atomicAdd(&(bar)[XB_TMO], 1u); break; } } } } while (0)
__device__ __forceinline__ void xcd_barrier_complete(unsigned* bar, unsigned x, unsigned& nloc, unsigned& nx) {
    const unsigned G = gridDim.x;
    unsigned sum, cnt, mine, sp = 0u;
    for (;;) {
        sum = 0u; cnt = 0u; mine = 0u;
#pragma unroll
        for (unsigned j = 0; j < 16; ++j) { const unsigned c = xb_ld(&bar[XB_XCNT(j)]); sum += c; cnt += (c > 0u) ? 1u : 0u; mine = (j == x) ? c : mine; }
        if (sum == G) break;
        __builtin_amdgcn_s_sleep(1);
        if ((++sp & 255u) == 0u) { if (xb_ld(&bar[XB_TMO])) break; if (sp > XB_SPIN_CAP) { atomicAdd(&bar[XB_TMO], 1u); break; } }
    }
    nloc = mine > 0u ? mine : 1u; nx = cnt > 0u ? cnt : 1u;
}
__device__ __forceinline__ void xcd_barrier(unsigned* bar, unsigned x, volatile LAS unsigned* st) {
    asm volatile("s_waitcnt vmcnt(0)" ::: "memory");
    __syncthreads();
    if (threadIdx.x == 0) {
        __builtin_amdgcn_s_waitcnt(0);
        unsigned nloc = st[0], nx = st[1];
        if (nloc == 0u) { xcd_barrier_complete(bar, x, nloc, nx); st[0] = nloc; st[1] = nx; }
        const unsigned old = xb_add(&bar[XB_XSUB(x)], 1u);
        const unsigned gen = old / nloc;
        if (old + 1u == (gen + 1u) * nloc) {
            __builtin_amdgcn_fence(__ATOMIC_RELEASE, "agent");
            asm volatile("s_waitcnt vmcnt(0)" ::: "memory");
            const unsigned og = xb_add(&bar[XB_TOP], 1u);
            const unsigned tg = og / nx;
            if (og + 1u == (tg + 1u) * nx) xb_add(&bar[XB_TOPGEN], 1u);
            else XB_SPIN(xb_ld(&bar[XB_TOPGEN]) == tg, bar);
            __builtin_amdgcn_fence(__ATOMIC_ACQUIRE, "agent");
            xb_add(&bar[XB_XGEN(x)], 1u);
            asm volatile("s_waitcnt vmcnt(0)" ::: "memory");
        } else {
            XB_SPIN(xb_ld(&bar[XB_XGEN(x)]) == gen, bar);
            __builtin_amdgcn_fence(__ATOMIC_ACQUIRE, "agent");
            asm volatile("s_waitcnt vmcnt(0)" ::: "memory");
        }
    }
    __syncthreads();
}
#define GRID_SYNC() xcd_barrier(gbar, xcc_, xst_)
#define PHASE_SYNC(n) do { if (p.ph_lo < (n) && (n) <= p.ph_hi) GRID_SYNC(); } while (0)
__global__ void __launch_bounds__(512) fwd_megakernel(Params p) {
    extern __shared__ __attribute__((aligned(16))) char shm[];
    cg::grid_group grid = cg::this_grid();
    if (p.ph_lo > 1000) grid.sync();
    unsigned* gbar = (unsigned*)(p.ws + WS_BAR);
    volatile LAS unsigned* xst_ = (volatile LAS unsigned*)(LAS char*)(shm + LDS_BYTES - 16);
    if (threadIdx.x == 0) { xst_[0] = 0u; xst_[1] = 0u; }
    __syncthreads();
    const unsigned xcc_ = xb_xcc_id();
    if (threadIdx.x == 0) (void)xb_add(&gbar[XB_XCNT(xcc_)], 1u);
    char* ws = p.ws;
    bf16_t* WinT = (bf16_t*)(ws + WS_WIN); bf16_t* WbrT = (bf16_t*)(ws + WS_WBRA);
    bf16_t* WoutT = (bf16_t*)(ws + WS_WOUT); bf16_t* WupT = (bf16_t*)(ws + WS_WUP); bf16_t* WdownT = (bf16_t*)(ws + WS_WDOWN);
    bf16_t* Hb = (bf16_t*)(ws + WS_H);
    bf16_t* Ob = (bf16_t*)(ws + WS_P + (size_t)MTOK * DM * 4);
    bf16_t* X1 = (bf16_t*)(ws + WS_P);
    bf16_t* QA = (bf16_t*)(ws + WS_QK); bf16_t* KA = QA + (size_t)MTOK * 1024; bf16_t* QB = KA + (size_t)MTOK * 256; bf16_t* KB = QB + (size_t)MTOK * 1024;
    bf16_t* VA = (bf16_t*)(ws + WS_V); bf16_t* VB = VA + (size_t)MTOK * 256;
    bf16_t* Gt = (bf16_t*)(ws + WS_G); bf16_t* Ub = (bf16_t*)(ws + WS_QK);
    bf16_t* Mb = (bf16_t*)(ws + WS_M);
    bf16_t* CAK = (bf16_t*)(ws + WS_CTX); bf16_t* CAV = CAK + 131072; bf16_t* CBK = CAV + 131072; bf16_t* CBV = CBK + 524288;
    float* mod = (float*)(ws + WS_MOD); float* ropeC = (float*)(ws + WS_ROPE); float* ropeS = ropeC + 2048;

    if (PHASE_ON(0)) REP(0) {
        int tid_ = threadIdx.x; asm volatile("" : "+v"(tid_)); const int tid = tid_, wid = tid >> 6, lane = tid & 63;
        constexpr int NGEMV = 192, NTR = 576;
#define WIN_QKV_ITEM(j) ((((j) / 18) * 34 + ((j) % 18)) * 4)
#define WIN_GATE_ITEM(j) ((((j) / 16) * 34 + 18 + ((j) % 16)) * 4)
        const int G = gridDim.x, bx = blockIdx.x;
        if (bx < NGEMV) {
            for (int s = bx; s < NGEMV; s += G) {
                float* red = (float*)shm;
                float* sil = (float*)shm + 2048;
                for (int e = tid; e < 6144; e += 512) { const int v = e >> 11, k = e & 2047; const float c = v == 0 ? p.c_ctx[k] : p.c[(v - 1) * 2048 + k]; sil[e] = c * sigmoidf_(c); }
                __syncthreads();
                const int kb = __builtin_amdgcn_readfirstlane(wid) * 256;
                const float* wp = p.w_ada + (size_t)kb * 12288 + s * 64 + lane;
                float a0 = 0.f, a1 = 0.f, a2 = 0.f;
#pragma unroll 32
                for (int i = 0; i < 256; ++i) {
                    const float w = __builtin_nontemporal_load(wp + (size_t)i * 12288);
                    a0 += sil[kb + i] * w; a1 += sil[2048 + kb + i] * w; a2 += sil[4096 + kb + i] * w;
                }
                red[(wid * 3 + 0) * 64 + lane] = a0; red[(wid * 3 + 1) * 64 + lane] = a1; red[(wid * 3 + 2) * 64 + lane] = a2;
                __syncthreads();
                if (tid < 192) { const int v = tid >> 6, col = tid & 63; const int n = s * 64 + col; float sum = p.b_ada[n];
#pragma unroll
                    for (int w = 0; w < 8; ++w) sum += red[(w * 3 + v) * 64 + col];
                    mod[v * 12288 + n] = sum; }
                __syncthreads();
            }
        }
        if (G > NGEMV) {
            if (bx >= NGEMV) { for (int it = bx - NGEMV; it < 256; it += G - NGEMV) transpose_item(p, WIN_QKV_ITEM(it), tid, shm); }
            else { for (int it = 256 + bx; it < NTR; it += NGEMV) transpose_item(p, WIN_QKV_ITEM(it), tid, shm); }
        } else { for (int it = bx; it < NTR; it += G) transpose_item(p, WIN_QKV_ITEM(it), tid, shm); }
        for (int i = blockIdx.x * 512 + tid; i < 327680; i += gridDim.x * 512) {
            const float* src; bf16_t* dst; int j = i;
            if (j < 32768) { src = p.cak; dst = CAK; } else if (j < 65536) { j -= 32768; src = p.cav; dst = CAV; }
            else if (j < 196608) { j -= 65536; src = p.cbk; dst = CBK; } else { j -= 196608; src = p.cbv; dst = CBV; }
            const f32x4 v = *(const f32x4*)(src + (size_t)j * 4);
            *(u32x2*)(dst + (size_t)j * 4) = (u32x2){cvtpk(v[0], v[1]), cvtpk(v[2], v[3])};
        }
        if (blockIdx.x == gridDim.x - 1) {
            for (int e = tid; e < 2048; e += 512) { const int pos = e >> 5, i = e & 31;
                const float inv = exp2f(-(float)i * (13.287712379549449f / 32.f));
                const float ang = (float)pos * inv;
                ropeC[e] = cosf(ang); ropeS[e] = sinf(ang); }
            float* normw = (float*)(ws + WS_NORMW);
            { const int e = tid; normw[e] = e < 128 ? p.qna[e] : e < 256 ? p.kna[e - 128] : e < 384 ? p.qnb[e - 256] : p.knb[e - 384]; }
        }
    }
    PHASE_SYNC(1);
#define NORM_PHASE(FIRST) do { \
        int tid_ = threadIdx.x; asm volatile("" : "+v"(tid_)); const int wid = tid_ >> 6, lane = tid_ & 63; \
        const float* nwp = (FIRST) ? p.norm1_w : p.norm2_w; const int shoff = (FIRST) ? 0 : 6144, scoff = (FIRST) ? 2048 : 8192; \
        for (int row = blockIdx.x * 8 + wid; row < MTOK; row += gridDim.x * 8) { \
            const float* xr = row < NPROMPT ? p.x_prompt + (size_t)row * DM : p.x_sample + (size_t)(row - NPROMPT) * DM; const bf16_t* xb = X1 + (size_t)row * DM; \
            const int v = row < NPROMPT ? 0 : 1 + ((row - NPROMPT) >> 10); \
            const float* md = mod + v * 12288; \
            f32x4 xv[8]; float ss = 0; \
            _Pragma("unroll") for (int i = 0; i < 8; ++i) { if (FIRST) xv[i] = __builtin_nontemporal_load((const f32x4*)(xr + (i * 64 + lane) * 4)); else { const u32x2 w_ = *(const u32x2*)(xb + (i * 64 + lane) * 4); xv[i] = (f32x4){__uint_as_float(w_[0] << 16), __uint_as_float(w_[0] & 0xffff0000u), __uint_as_float(w_[1] << 16), __uint_as_float(w_[1] & 0xffff0000u)}; } ss += xv[i][0] * xv[i][0] + xv[i][1] * xv[i][1] + xv[i][2] * xv[i][2] + xv[i][3] * xv[i][3]; } \
            ss = wave_sum(ss); \
            const float rstd = rsqrtf(ss * (1.f / 2048.f) + 1e-6f); \
            _Pragma("unroll") for (int i = 0; i < 8; ++i) { const int c = (i * 64 + lane) * 4; \
                const f32x4 nw = *(const f32x4*)(nwp + c), sc = *(const f32x4*)(md + scoff + c), sh = *(const f32x4*)(md + shoff + c); \
                f32x4 h; \
                _Pragma("unroll") for (int j = 0; j < 4; ++j) h[j] = (xv[i][j] * rstd * nw[j]) * (1.f + sc[j]) + sh[j]; \
                *(u32x2*)(Hb + (size_t)row * DM + c) = (u32x2){cvtpk(h[0], h[1]), cvtpk(h[2], h[3])}; } \
        } } while (0)
    if (PHASE_ON(1)) REP(1) NORM_PHASE(true);
    PHASE_SYNC(2);
    if (PHASE_ON(2)) REP(2) {
        pg8::StaticOrder S; S.init(MTOK, 4608, gridDim.x, blockIdx.x);
        Epi1 E{ws, p.out, (float*)(shm + 131072)};
        pg8::gemm_phase((LAS unsigned char*)shm, pg8::Gemm{Hb, WinT, MTOK, 4608, DM, DM}, S, E);
        const int nfour = (MTOK / 256) * (4608 / 256) - 1 * (int)gridDim.x;
        if (nfour > 0 && nfour < (int)gridDim.x) {
            if ((int)blockIdx.x >= nfour) { int tid_ = threadIdx.x; asm volatile("" : "+v"(tid_));
                for (int it = blockIdx.x - nfour; it < 1024; it += gridDim.x - nfour) transpose_item(p, 6400 + it * 4, tid_, shm);
                for (int it = blockIdx.x - nfour; it < 512; it += gridDim.x - nfour) transpose_item(p, WIN_GATE_ITEM(it), tid_, shm); }
        } else { int tid_ = threadIdx.x; asm volatile("" : "+v"(tid_));
            for (int it = blockIdx.x; it < 1024; it += gridDim.x) transpose_item(p, 6400 + it * 4, tid_, shm);
            for (int it = blockIdx.x; it < 512; it += gridDim.x) transpose_item(p, WIN_GATE_ITEM(it), tid_, shm); }
    }
    PHASE_SYNC(3);
    if (PHASE_ON(3)) REP(3) {
        int tid_ = threadIdx.x; asm volatile("" : "+v"(tid_)); const int wid = tid_ >> 6, lane = tid_ & 63;
        for (int row = NPROMPT + blockIdx.x * 8 + wid; row < MTOK; row += gridDim.x * 8) {
            const int t = (row - NPROMPT) & 1023; const int gr = t >> 6, gc = t & 63; const int fi = lane & 31;
            const float c0 = ropeC[gr * 32 + fi], s0 = ropeS[gr * 32 + fi], c1 = ropeC[gc * 32 + fi], s1 = ropeS[gc * 32 + fi];
#pragma unroll
            for (int hv = 0; hv < 10; ++hv) {
                bf16_t* d = hv < 8 ? QA + (size_t)row * 1024 + hv * 128 : KA + (size_t)row * 256 + (hv - 8) * 128;
                float a = __uint_as_float(((unsigned)d[lane]) << 16), b = __uint_as_float(((unsigned)d[64 + lane]) << 16);
                const float pa = __shfl_xor(a, 32), pb = __shfl_xor(b, 32);
                if (lane < 32) { a = a * c0 - pa * s0; b = b * c1 - pb * s1; }
                else { a = pa * s0 + a * c0; b = pb * s1 + b * c1; }
                d[lane] = f2bf(a); d[64 + lane] = f2bf(b);
            }
        }
    }
    PHASE_SYNC(4);
    if (PHASE_ON(4)) REP(4) {
        { pg8::StaticOrder S; S.init(MTOK, 4096, gridDim.x, blockIdx.x);
          EpiGate E{Gt};
          pg8::gemm_phase((LAS unsigned char*)shm, pg8::Gemm{Hb, WinT + (size_t)4608 * DM, MTOK, 4096, DM, DM}, S, E); }
        const int abx = ((int)gridDim.x == 256) ? ((int)blockIdx.x ^ 128) : (int)blockIdx.x;
        for (int slot = abx; slot < 512; slot += gridDim.x) {
            const bf16_t *Qp, *Kl, *Vl, *Kc, *Vc; bf16_t* Op; int LDK, nctx, loc0, NT, mode, qbase, h; bool isA;
            if (slot < 64) {
                const int b = (slot >> 3) & 1, g = slot >> 4; h = slot & 7; const size_t rb = NPROMPT + (size_t)b * 1024; isA = false;
                loc0 = (g < 2 ? 0 : (g == 2 ? 4 : 8)) * 64; NT = 4 + ((g == 0 || g == 3) ? 8 : 12); nctx = 4; mode = 2; qbase = 256 * g; LDK = 1024;
                Qp = QB + (rb + 256 * g) * 1024 + h * 128; Kl = KB + rb * 1024 + h * 128; Vl = VB + rb * 1024 + h * 128;
                Kc = CBK + (size_t)b * 262144 + h * 128; Vc = CBV + (size_t)b * 262144 + h * 128; Op = Ob + (rb + 256 * g) * 2048 + 1024 + h * 128;
            } else if (slot < 128) {
                const int s = slot - 64; const int b = (s >> 3) & 1, cch = s >> 4; h = s & 7; const size_t rb = NPROMPT + (size_t)b * 1024; isA = true;
                loc0 = max(0, 256 * cch - 128); const int lend = min(1024, 256 * cch + 384); NT = 4 + (lend - loc0) / 64; nctx = 4; mode = 1; qbase = 256 * cch; LDK = 256;
                Qp = QA + (rb + 256 * cch) * 1024 + h * 128; Kl = KA + rb * 256 + (h >> 2) * 128; Vl = VA + rb * 256 + (h >> 2) * 128;
                Kc = CAK + (size_t)b * 65536 + (h >> 2) * 128; Vc = CAV + (size_t)b * 65536 + (h >> 2) * 128; Op = Ob + (rb + 256 * cch) * 2048 + h * 128;
            } else {
                int pi;
                if (slot < 256) pi = slot - 128; else if (slot >= 384) pi = slot - 256; else continue;
                isA = pi < 128; if (!isA) pi -= 128;
                const int b = isA ? ((pi >> 5) << 2) + ((pi & 7) >> 1) : pi >> 3; h = isA ? ((pi & 1) << 2) + ((pi >> 3) & 3) : pi & 7; const size_t rb = (size_t)b * 256;
                loc0 = 0; NT = 4; nctx = 0; mode = 0; qbase = 0;
                if (isA) { LDK = 256; Qp = QA + rb * 1024 + h * 128; Kl = KA + rb * 256 + (h >> 2) * 128; Vl = VA + rb * 256 + (h >> 2) * 128; Op = Ob + rb * 2048 + h * 128; }
                else { LDK = 1024; Qp = QB + rb * 1024 + h * 128; Kl = KB + rb * 1024 + h * 128; Vl = VB + rb * 1024 + h * 128; Op = Ob + rb * 2048 + 1024 + h * 128; }
                Kc = Kl; Vc = Vl;
            }
            attn_item(Qp, Kl, Vl, Kc, Vc, Op, LDK, nctx, loc0, NT, mode, qbase, isA, isA ? p.sink_a[h] * LOG2E : 0.f, p.rpb + h * 465, shm);
        }
        { const int nheavy = gridDim.x >> 1; int tid_ = threadIdx.x; asm volatile("" : "+v"(tid_));
          __syncthreads();
          if (abx < nheavy) for (int it = abx; it < 512; it += nheavy) transpose_item(p, 4352 + it * 4, tid_, shm); }
    }
    PHASE_SYNC(5);
    if (PHASE_ON(5)) REP(5) {
        pg8::StaticOrder S; S.init(MTOK, DM, gridDim.x, blockIdx.x, 2, 192);
        EpiMerge<true> E{Gt, Mb};
        pg8::gemm_phase<EpiMerge<true>, true, true>((LAS unsigned char*)shm, pg8::Gemm{Ob, WbrT, MTOK, DM, 1024, DM}, S, E);
        W_DOWN_PART(0);
    }
    PHASE_SYNC(6);
    if (PHASE_ON(6)) REP(6) {
        pg8::StaticOrder S; S.init(MTOK, DM, gridDim.x, blockIdx.x, 1, 192);
        EpiRes<true, false, true> E{p.x_prompt, p.x_sample, mod, 4096, X1};
        pg8::gemm_phase<EpiRes<true, false, true>, false, true>((LAS unsigned char*)shm, pg8::Gemm{Mb, WoutT, MTOK, DM, DM, DM}, S, E);
        W_DOWN_PART(1);
    }
    PHASE_SYNC(7);
    if (PHASE_ON(7)) REP(7) NORM_PHASE(false);
    PHASE_SYNC(8);
    if (PHASE_ON(8)) REP(8) {
        pg8::StaticOrder S; S.init(MTOK, DFF, gridDim.x, blockIdx.x);
        EpiUp E{Ub};
        pg8::gemm_phase((LAS unsigned char*)shm, pg8::Gemm{Hb, WupT, MTOK, DFF, DM, DM}, S, E);
    }
    PHASE_SYNC(9);
    if (PHASE_ON(9)) REP(9) {
        pg8::StaticOrder S; S.init(MTOK, DM, gridDim.x, blockIdx.x, 1, 192);
        EpiRes<true, true, false> E{X1, X1 + (size_t)NPROMPT * DM, mod, 10240, p.out + OUT_YP};
        pg8::gemm_phase<EpiRes<true, true, false>, false, true>((LAS unsigned char*)shm, pg8::Gemm{Ub, WdownT, MTOK, DM, DFF, DFF}, S, E);
    }
}

extern "C" void kernel_launch(void* const* d_in, const int* in_sizes, int n_in, void* d_out, int out_size, void* d_ws, size_t ws_size, hipStream_t stream) {
    static int grid_blocks = 0;
    if (!grid_blocks) {
        if (n_in != 24 || ws_size < WS_END) { fprintf(stderr, "kernel_launch: unexpected n_in %d / ws_size %zu (need %zu)\n", n_in, ws_size, (size_t)WS_END); return; }
        int dev = 0, cus = 0, per_cu = 0;
        hipGetDevice(&dev);
        hipDeviceGetAttribute(&cus, hipDeviceAttributeMultiprocessorCount, dev);
        if (hipFuncSetAttribute((const void*)fwd_megakernel, hipFuncAttributeMaxDynamicSharedMemorySize, LDS_BYTES) != hipSuccess) { fprintf(stderr, "kernel_launch: hipFuncSetAttribute failed\n"); return; }
        hipOccupancyMaxActiveBlocksPerMultiprocessor(&per_cu, (const void*)fwd_megakernel, 512, LDS_BYTES);
        if (per_cu < 1) per_cu = 1;
        grid_blocks = cus;
    }
    Params p{};
    const float** f = (const float**)&p;
    for (int i = 0; i < 24; ++i) f[i] = (const float*)d_in[i];
    p.out = (float*)d_out; p.ws = (char*)d_ws; p.ph_lo = 0; p.ph_hi = 9;
    hipMemsetAsync((char*)d_ws + WS_BAR, 0, 16384, stream);
    void* args[] = {&p};
    hipError_t e = hipLaunchCooperativeKernel((const void*)fwd_megakernel, dim3(grid_blocks), dim3(512), args, LDS_BYTES, stream);
    if (e != hipSuccess) fprintf(stderr, "cooperative launch failed: %s (grid %d)\n", hipGetErrorString(e), grid_blocks);
}
```

```cpp
#include <hip/hip_runtime.h>
#include <hip/hip_cooperative_groups.h>
#include <cstdio>
namespace cg = cooperative_groups;

typedef unsigned short bf16_t;
typedef short bf16x8 __attribute__((ext_vector_type(8)));
typedef short s16x4 __attribute__((ext_vector_type(4)));
typedef float f32x4 __attribute__((ext_vector_type(4)));
typedef float f32x16 __attribute__((ext_vector_type(16)));
typedef unsigned u32x4 __attribute__((ext_vector_type(4)));
typedef unsigned u32x2 __attribute__((ext_vector_type(2)));
typedef float f32x2 __attribute__((ext_vector_type(2)));
#define LAS __attribute__((address_space(3)))

constexpr int DM = 2048, NPROMPT = 4096, MTOK = 6144, INW = 8704, DFF = 8192, PW = 3328;
constexpr float LOG2E = 1.4426950408889634f;
constexpr float SM_SCALE = 0.088388347648318440f;
constexpr float NEGBIG = -1e30f;

constexpr size_t SZ_WIN = (size_t)INW * DM * 2, SZ_WBR = (size_t)DM * 1024 * 2, SZ_WOUT = (size_t)DM * DM * 2, SZ_WUP = (size_t)DFF * DM * 2;
constexpr size_t WS_WIN = 0;
constexpr size_t WS_WBRA = WS_WIN + SZ_WIN;
constexpr size_t WS_WBRB = WS_WBRA + SZ_WBR;
constexpr size_t WS_WOUT = WS_WBRB + SZ_WBR;
constexpr size_t WS_WUP = WS_WOUT + SZ_WOUT;
constexpr size_t WS_WDOWN = WS_WUP + SZ_WUP;
constexpr size_t WS_H = WS_WDOWN + SZ_WUP;
constexpr size_t WS_P = WS_H + (size_t)MTOK * DM * 2;
static_assert((size_t)MTOK * DM * 4 + (size_t)MTOK * DM * 2 <= (size_t)MTOK * PW * 4, "X1 + O fit the WS_P region");
constexpr size_t WS_QK = WS_P + (size_t)MTOK * PW * 4;
constexpr size_t WS_V = WS_QK + (size_t)MTOK * PW * 2;
constexpr size_t WS_G = WS_V + (size_t)MTOK * 1280 * 2;
constexpr size_t WS_M = WS_G + (size_t)MTOK * 4096 * 2;
constexpr size_t WS_CTX = WS_M + (size_t)MTOK * DM * 2;
constexpr size_t WS_MOD = WS_CTX + (size_t)2 * 256 * (256 * 2 + 1024 * 2) * 2;
constexpr size_t WS_ROPE = WS_MOD + (size_t)3 * 12288 * 4;
constexpr size_t WS_NORMW = WS_ROPE + 2 * 64 * 32 * 4;
constexpr size_t WS_BAR = WS_NORMW + 2048;
constexpr size_t WS_END = WS_BAR + 16384;
static_assert((size_t)MTOK * DFF * 2 <= WS_M - WS_QK, "U overlay");

constexpr int OUT_YP = 0, OUT_AK = 12582912, OUT_AV = 13631488, OUT_BK = 14680064, OUT_BV = 18874368;

constexpr int LDS_BYTES = 131072 + 8192 + 256;

struct Params {
    const float *x_prompt, *x_sample, *cak, *cav, *cbk, *cbv, *c, *c_ctx, *norm1_w, *norm2_w, *w_ada, *b_ada, *w_in,
        *qna, *kna, *qnb, *knb, *sink_a, *rpb, *w_br_a, *w_br_b, *w_out, *w_up, *w_down;
    float* out; char* ws; int ph_lo, ph_hi;
};

typedef __bf16 bf16x2_t __attribute__((ext_vector_type(2)));
__device__ __forceinline__ unsigned cvtpk(float lo, float hi) { f32x2 v = {lo, hi}; bf16x2_t b = __builtin_convertvector(v, bf16x2_t); return __builtin_bit_cast(unsigned, b); }
__device__ __forceinline__ bf16_t f2bf(float f) { return (bf16_t)(cvtpk(f, 0.f) & 0xffffu); }
__device__ __forceinline__ float wave_sum(float v) {
#pragma unroll
    for (int o = 32; o > 0; o >>= 1) v += __shfl_xor(v, o);
    return v;
}
__device__ __forceinline__ float sigmoidf_(float x) { return __builtin_amdgcn_rcpf(1.f + __expf(-x)); }

namespace pg8 {
constexpr int BM = 256, BK = 64, HALF = 128, HTB = HALF * BK * 2, STAGE_BYTES = 8 * HTB, NXCD = 8, WGM = 4;
__device__ __forceinline__ int lds_byte(int r, int c) { const int st = (r >> 4) * 2 + (c >> 5), rr = r & 15, cc = c & 31, ob = rr * 64 + cc * 2; return st * 1024 + (ob ^ (((ob >> 9) & 1) << 5)); }
__device__ __forceinline__ void stage_rc(int b, int& R, int& C) { const int st = b / 1024, sb = b % 1024, swz = sb ^ (((sb >> 9) & 1) << 5); R = (st >> 1) * 16 + swz / 64; C = (st & 1) * 32 + (swz % 64) / 2; }
__device__ __forceinline__ int perm32(int rho) { const int n = rho >> 4, i = rho & 15; return 8 * (i >> 2) + 4 * n + (i & 3); }
struct Unit { int pm, pn, part; };
struct Gemm { const bf16_t* A; const bf16_t* Bt; int M, N, K, ld; };
struct StaticOrder {
    int nM, nN, nwg, G, c, parts;
    __device__ void init(int M, int N, int G_, int c_, int parts_ = 1, int tile_rows = BM) { nM = M / tile_rows; nN = N / BM; nwg = nM * nN; G = G_; c = c_; parts = parts_; }
    __device__ bool next(int i, Unit& u) const {
        u.part = (parts == 2) ? (i & 1) : 0; if (parts == 2) i >>= 1;
        const long L = (long)i * G + c; if (L >= nwg) return false;
        int wgid = (int)L; { const int q = nwg / NXCD, r = nwg % NXCD, xcd = wgid % NXCD, off = wgid / NXCD; wgid = (xcd < r ? xcd * (q + 1) : r * (q + 1) + (xcd - r) * q) + off; }
        const int nig = WGM * nN, gid = wgid / nig, fm = gid * WGM, gsz = (nM - fm) < WGM ? (nM - fm) : WGM;
        u.pm = fm + ((wgid % nig) % gsz); u.pn = (wgid % nig) / gsz; return true;
    }
};

template <class Epi, bool TWOPART = false, bool T192 = false>
__device__ __forceinline__ void gemm_phase(LAS unsigned char* lds, const Gemm g, const StaticOrder& S, const Epi& E) {
    int tid_ = threadIdx.x; asm volatile("" : "+v"(tid_));
    const int tid = tid_, wid = __builtin_amdgcn_readfirstlane(tid >> 6), lane = tid & 63, wr = wid >> 2, wc = wid & 3, fr = lane & 15, fq = lane >> 4;
    const int K = g.K, nt = K / BK;
    constexpr int M1 = T192 ? 2 : 4;
    unsigned voffA[2], voffA1[2], voffB[2];
#pragma unroll
    for (int i = 0; i < 2; ++i) { int R, C; stage_rc(tid * 16 + i * 8192, R, C); const int Rb = (R & ~31) + perm32(R & 31);
        const int R1 = T192 ? ((R & 31) + 32 * ((R >> 6) & 1)) : R;
        voffA[i] = (unsigned)(R * g.ld + C) * 2u; voffA1[i] = (unsigned)(R1 * g.ld + C) * 2u; voffB[i] = (unsigned)(Rb * g.ld + C) * 2u; }
    const size_t kstep = (size_t)(BK * 2);
    const size_t hstep = (size_t)HALF * g.ld * 2;
    const size_t pstep = (size_t)K * 2;
    const size_t tstep = 2 * hstep;
    const size_t tstepA = T192 ? (size_t)192 * g.ld * 2 : tstep;
    const unsigned ldsw = (unsigned)wid * 1024u;
    const int aoff = lds_byte(wr * 64 + fr, fq * 8), boff = lds_byte(wc * 32 + fr, fq * 8);
#define PG8_SA(b, h) (((b) * 2 + (h)) * HTB)
#define PG8_SB(b, h) ((4 + (b) * 2 + (h)) * HTB)
#define PG8_STAGE(bufoff, gbase, voff) do { _Pragma("unroll") for (int _i = 0; _i < 2; ++_i) \
        __builtin_amdgcn_global_load_lds((const unsigned*)((const char*)(gbase) + (voff)[_i]), (LAS unsigned*)(lds + (bufoff) + ldsw + _i * 8192), 16, 0, 0); } while (0)
#define PG8_LDA(dst, b, h) do { _Pragma("unroll") for (int m = 0; m < ((h) ? M1 : 4); ++m) _Pragma("unroll") for (int k = 0; k < 2; ++k) dst[m][k] = *(const LAS bf16x8*)(lds + PG8_SA(b, h) + aoff + m * 2048 + k * 1024); } while (0)
#define PG8_LDB(dst, b, h) do { _Pragma("unroll") for (int n = 0; n < 2; ++n) _Pragma("unroll") for (int k = 0; k < 2; ++k) dst[n][k] = *(const LAS bf16x8*)(lds + PG8_SB(b, h) + boff + n * 2048 + k * 1024); } while (0)
#define PG8_MMA(ai, bj, At, Bt) do { __builtin_amdgcn_s_setprio(1); _Pragma("unroll") for (int m = 0; m < ((ai) ? M1 : 4); ++m) _Pragma("unroll") for (int n = 0; n < 2; ++n) _Pragma("unroll") for (int k = 0; k < 2; ++k) \
        acc[ai][bj][m][n] = __builtin_amdgcn_mfma_f32_16x16x32_bf16(Bt[n][k], At[m][k], acc[ai][bj][m][n], 0, 0, 0); __builtin_amdgcn_s_setprio(0); } while (0)
#define PG8_WAIT_V(n) asm volatile("s_waitcnt vmcnt(" #n ")" ::: "memory")
#define PG8_WAIT_L(n) asm volatile("s_waitcnt lgkmcnt(" #n ")" ::: "memory")
#define PG8_BAR __builtin_amdgcn_s_barrier()
#define PG8_SCHED __builtin_amdgcn_sched_barrier(0)
    Unit cur, nxt; int ui = 0;
    if (!S.next(0, cur)) return;
    f32x4 acc[2][2][4][2];
#pragma unroll
    for (int a = 0; a < 2; ++a)
#pragma unroll
        for (int b = 0; b < 2; ++b)
#pragma unroll
            for (int m = 0; m < 4; ++m)
#pragma unroll
                for (int n = 0; n < 2; ++n) acc[a][b][m][n] = (f32x4){0.f, 0.f, 0.f, 0.f};
    bf16x8 At[4][2], B0[2][2], B1[2][2];
    const char* cA = (const char*)g.A + (size_t)cur.pm * tstepA + cur.part * pstep; const char* cB = (const char*)g.Bt + (size_t)cur.pn * tstep + cur.part * pstep;
    PG8_STAGE(PG8_SB(0, 0), cB, voffB); PG8_STAGE(PG8_SA(0, 0), cA, voffA); PG8_STAGE(PG8_SB(0, 1), cB + hstep, voffB); PG8_STAGE(PG8_SA(0, 1), cA + hstep, voffA1);
    if (wr == 1) PG8_BAR;
    PG8_WAIT_V(4); PG8_BAR;
    PG8_STAGE(PG8_SB(1, 0), cB + kstep, voffB); PG8_STAGE(PG8_SA(1, 0), cA + kstep, voffA); PG8_STAGE(PG8_SB(1, 1), cB + hstep + kstep, voffB);
    PG8_WAIT_V(6); PG8_BAR;
    for (;;) {
        const bool has_next = S.next(ui + 1, nxt);
        const char* nA = has_next ? (const char*)g.A + (size_t)nxt.pm * tstepA + nxt.part * pstep : cA; const char* nB = has_next ? (const char*)g.Bt + (size_t)nxt.pn * tstep + nxt.part * pstep : cB;
        for (int t = 0; t < nt; t += 2) {
            const bool last = (t == nt - 2);
            const char* a1 = cA + (size_t)(t + 1) * kstep;
            const char* a2 = last ? nA : cA + (size_t)(t + 2) * kstep; const char* b2 = last ? nB : cB + (size_t)(t + 2) * kstep;
            const char* a3 = a2 + kstep; const char* b3 = b2 + kstep;
            PG8_LDB(B0, 0, 0); PG8_SCHED; PG8_LDA(At, 0, 0); PG8_STAGE(PG8_SA(1, 1), a1 + hstep, voffA1);
            PG8_WAIT_L(8); PG8_BAR; PG8_MMA(0, 0, At, B0); PG8_BAR; PG8_SCHED;
            PG8_LDB(B1, 0, 1); PG8_STAGE(PG8_SB(0, 0), b2, voffB);
            PG8_BAR; PG8_MMA(0, 1, At, B1); PG8_BAR;
            PG8_LDA(At, 0, 1); PG8_STAGE(PG8_SA(0, 0), a2, voffA);
            PG8_BAR; PG8_MMA(1, 0, At, B0); PG8_BAR; PG8_SCHED;
            PG8_STAGE(PG8_SB(0, 1), b2 + hstep, voffB);
            PG8_WAIT_V(6); PG8_BAR; PG8_MMA(1, 1, At, B1); PG8_BAR;
            PG8_LDB(B0, 1, 0); PG8_SCHED; PG8_LDA(At, 1, 0); PG8_STAGE(PG8_SA(0, 1), a2 + hstep, voffA1);
            PG8_WAIT_L(8); PG8_BAR; PG8_MMA(0, 0, At, B0); PG8_BAR; PG8_SCHED;
            PG8_LDB(B1, 1, 1); PG8_STAGE(PG8_SB(1, 0), b3, voffB);
            PG8_BAR; PG8_MMA(0, 1, At, B1); PG8_BAR;
            PG8_LDA(At, 1, 1); PG8_STAGE(PG8_SA(1, 0), a3, voffA);
            PG8_BAR; PG8_MMA(1, 0, At, B0); PG8_BAR; PG8_SCHED;
            PG8_STAGE(PG8_SB(1, 1), b3 + hstep, voffB);
            PG8_WAIT_V(6); PG8_BAR; PG8_MMA(1, 1, At, B1); PG8_BAR;
        }
        E(acc, cur, wr, wc, fr, fq);
        if (!has_next) break;
        if (!(TWOPART && cur.part == 0))
#pragma unroll
        for (int a = 0; a < 2; ++a)
#pragma unroll
            for (int b = 0; b < 2; ++b)
#pragma unroll
                for (int m = 0; m < 4; ++m)
#pragma unroll
                    for (int n = 0; n < 2; ++n) acc[a][b][m][n] = (f32x4){0.f, 0.f, 0.f, 0.f};
        cur = nxt; cA = nA; cB = nB; ++ui;
    }
    PG8_WAIT_V(0);
    if (wr == 0) PG8_BAR;
    PG8_BAR;
#undef PG8_SA
#undef PG8_SB
#undef PG8_STAGE
#undef PG8_LDA
#undef PG8_LDB
#undef PG8_MMA
#undef PG8_WAIT_V
#undef PG8_WAIT_L
#undef PG8_BAR
#undef PG8_SCHED
}
}
using pg8::Unit;
typedef f32x4 AccT[2][2][4][2];

__device__ __forceinline__ u32x4 pack8(f32x4 a, f32x4 b) { return (u32x4){cvtpk(a[0], a[1]), cvtpk(a[2], a[3]), cvtpk(b[0], b[1]), cvtpk(b[2], b[3])}; }
__device__ __forceinline__ void unpack8(u32x4 w, f32x4& a, f32x4& b) {
    a = (f32x4){__uint_as_float(w[0] << 16), __uint_as_float(w[0] & 0xffff0000u), __uint_as_float(w[1] << 16), __uint_as_float(w[1] & 0xffff0000u)};
    b = (f32x4){__uint_as_float(w[2] << 16), __uint_as_float(w[2] & 0xffff0000u), __uint_as_float(w[3] << 16), __uint_as_float(w[3] & 0xffff0000u)};
}

struct Epi1 {
    char* ws; float* out; float* red;
    __device__ __forceinline__ void operator()(const AccT& acc, const Unit& u, int wr, int wc, int fr, int fq) const {
        const int pn = u.pn, row0 = u.pm * 256 + wr * 64 + fr, cin = wc * 32 + 8 * fq;
        bf16_t* QA = (bf16_t*)(ws + WS_QK); bf16_t* KA = QA + (size_t)MTOK * 1024; bf16_t* QB = KA + (size_t)MTOK * 256; bf16_t* KB = QB + (size_t)MTOK * 1024;
        bf16_t* VA = (bf16_t*)(ws + WS_V); bf16_t* VB = VA + (size_t)MTOK * 256; bf16_t* G = (bf16_t*)(ws + WS_G);
        float* out_ak = out + OUT_AK; float* out_bk = out + OUT_BK; float* out_av = out + OUT_AV; float* out_bv = out + OUT_BV;
        if (pn < 5 || (pn >= 6 && pn < 14)) {
#pragma unroll
            for (int ai = 0; ai < 2; ++ai)
#pragma unroll
                for (int m = 0; m < 4; ++m)
#pragma unroll
                    for (int bj = 0; bj < 2; ++bj) { const f32x4 a = acc[ai][bj][m][0], b = acc[ai][bj][m][1];
                        float s = a[0] * a[0] + a[1] * a[1] + a[2] * a[2] + a[3] * a[3] + b[0] * b[0] + b[1] * b[1] + b[2] * b[2] + b[3] * b[3];
                        s += __shfl_xor(s, 16); s += __shfl_xor(s, 32);
                        if (fq == 0) red[((((wr * 8 + ai * 4 + m) * 16 + fr) * 2 + bj) * 4) + wc] = s; }
            asm volatile("s_waitcnt lgkmcnt(0)" ::: "memory"); __builtin_amdgcn_s_barrier(); asm volatile("" ::: "memory");
            const bool isK = (pn == 4 || pn >= 10), brA = (pn < 5);
            const float* nwp = (const float*)(ws + WS_NORMW) + ((brA ? 0 : 256) + (isK ? 128 : 0));
            const f32x4 w0 = *(const f32x4*)(nwp + cin), w1 = *(const f32x4*)(nwp + cin + 4);
            bf16_t* db = brA ? (isK ? KA : QA) : (isK ? KB : QB); const int ld = (brA && isK) ? 256 : 1024;
            const int dcol = (pn < 4 ? pn * 256 : pn == 4 ? 0 : pn < 10 ? (pn - 6) * 256 : (pn - 10) * 256) + cin;
            float* ob = brA ? out_ak : out_bk; const bool wout = isK && (u.pm < 16);
#pragma unroll
            for (int ai = 0; ai < 2; ++ai)
#pragma unroll
                for (int m = 0; m < 4; ++m) { const size_t ro = (size_t)(row0 + ai * 128 + m * 16) * ld + dcol;
#pragma unroll
                    for (int bj = 0; bj < 2; ++bj) {
                        const f32x4 pr = *(const f32x4*)(red + ((((wr * 8 + ai * 4 + m) * 16 + fr) * 2 + bj) * 4));
                        const float rstd = rsqrtf((pr[0] + pr[1] + pr[2] + pr[3]) * (1.f / 128.f) + 1e-6f);
                        const f32x4 v0 = acc[ai][bj][m][0] * rstd * w0, v1 = acc[ai][bj][m][1] * rstd * w1;
                        *(u32x4*)(db + ro + bj * 128) = pack8(v0, v1);
                        if (wout) { *(f32x4*)(ob + ro + bj * 128) = v0; *(f32x4*)(ob + ro + bj * 128 + 4) = v1; } } }
        } else if (pn < 18) {
            const bool isA = (pn == 5); const int ld = isA ? 256 : 1024; const int vcol = (isA ? 0 : (pn - 14) * 256) + cin;
            bf16_t* vb = isA ? VA : VB; float* ob = isA ? out_av : out_bv; const bool wout = (u.pm < 16);
#pragma unroll
            for (int ai = 0; ai < 2; ++ai)
#pragma unroll
                for (int m = 0; m < 4; ++m) { const size_t ro = (size_t)(row0 + ai * 128 + m * 16) * ld + vcol;
#pragma unroll
                    for (int bj = 0; bj < 2; ++bj) { *(u32x4*)(vb + ro + bj * 128) = pack8(acc[ai][bj][m][0], acc[ai][bj][m][1]);
                        if (wout) { *(f32x4*)(ob + ro + bj * 128) = acc[ai][bj][m][0]; *(f32x4*)(ob + ro + bj * 128 + 4) = acc[ai][bj][m][1]; } } }
        } else {
            const int gcol = (pn - 18) * 256 + cin;
#pragma unroll
            for (int ai = 0; ai < 2; ++ai)
#pragma unroll
                for (int m = 0; m < 4; ++m) { bf16_t* rp = G + (size_t)(row0 + ai * 128 + m * 16) * 4096 + gcol;
#pragma unroll
                    for (int bj = 0; bj < 2; ++bj) { f32x4 a = acc[ai][bj][m][0], b = acc[ai][bj][m][1];
#pragma unroll
                        for (int j = 0; j < 4; ++j) { a[j] = sigmoidf_(a[j]); b[j] = sigmoidf_(b[j]); }
                        *(u32x4*)(rp + bj * 128) = pack8(a, b); } }
        }
    }
};
struct EpiGate {
    bf16_t* G;
    __device__ __forceinline__ void operator()(const AccT& acc, const Unit& u, int wr, int wc, int fr, int fq) const {
        const int row0 = u.pm * 256 + wr * 64 + fr, gcol = u.pn * 256 + wc * 32 + 8 * fq;
#pragma unroll
        for (int ai = 0; ai < 2; ++ai)
#pragma unroll
            for (int m = 0; m < 4; ++m) { bf16_t* rp = G + (size_t)(row0 + ai * 128 + m * 16) * 4096 + gcol;
#pragma unroll
                for (int bj = 0; bj < 2; ++bj) { f32x4 a = acc[ai][bj][m][0], b = acc[ai][bj][m][1];
#pragma unroll
                    for (int j = 0; j < 4; ++j) { a[j] = sigmoidf_(a[j]); b[j] = sigmoidf_(b[j]); }
                    *(u32x4*)(rp + bj * 128) = pack8(a, b); } }
    }
};
template <bool T192> __device__ __forceinline__ int tile_row(int pm, int wr, int fr, int ai, int m) {
    return T192 ? pm * 192 + (ai ? 128 + 32 * wr : 64 * wr) + 16 * m + fr : pm * 256 + 128 * ai + 64 * wr + 16 * m + fr;
}
template <bool T192> struct EpiMerge {
    const bf16_t* G; bf16_t* Mo;
    __device__ __forceinline__ void operator()(AccT& acc, const Unit& u, int wr, int wc, int fr, int fq) const {
        const int col0 = u.pn * 256 + wc * 32 + 8 * fq;
        if (u.part == 0) {
#pragma unroll
            for (int ai = 0; ai < 2; ++ai)
#pragma unroll
                for (int m = 0; m < ((ai && T192) ? 2 : 4); ++m) { const size_t r = (size_t)tile_row<T192>(u.pm, wr, fr, ai, m);
#pragma unroll
                    for (int bj = 0; bj < 2; ++bj) { const int c = col0 + bj * 128; f32x4 a0, a1, b0, b1;
                        unpack8(*(const u32x4*)(G + r * 4096 + c), a0, a1); unpack8(*(const u32x4*)(G + r * 4096 + 2048 + c), b0, b1);
#pragma unroll
                        for (int j = 0; j < 4; ++j) { acc[ai][bj][m][0][j] *= a0[j] * __builtin_amdgcn_rcpf(fmaxf(b0[j], 1e-30f)); acc[ai][bj][m][1][j] *= a1[j] * __builtin_amdgcn_rcpf(fmaxf(b1[j], 1e-30f)); } } }
            return;
        }
#pragma unroll
        for (int ai = 0; ai < 2; ++ai)
#pragma unroll
            for (int m = 0; m < ((ai && T192) ? 2 : 4); ++m) { const size_t r = (size_t)tile_row<T192>(u.pm, wr, fr, ai, m);
#pragma unroll
                for (int bj = 0; bj < 2; ++bj) { const int c = col0 + bj * 128; f32x4 b0, b1; unpack8(*(const u32x4*)(G + r * 4096 + 2048 + c), b0, b1);
                    *(u32x4*)(Mo + r * DM + c) = pack8(acc[ai][bj][m][0] * b0, acc[ai][bj][m][1] * b1); } }
    }
};
template <bool T192, bool XBF = false, bool OBF = false> struct EpiRes {
    const void* Xp; const void* Xs; const float* mod; int goff; void* O;
    __device__ __forceinline__ void operator()(const AccT& acc, const Unit& u, int wr, int wc, int fr, int fq) const {
        const int col0 = u.pn * 256 + wc * 32 + 8 * fq;
#pragma unroll
        for (int ai = 0; ai < 2; ++ai)
#pragma unroll
            for (int m = 0; m < ((ai && T192) ? 2 : 4); ++m) { const int ri = tile_row<T192>(u.pm, wr, fr, ai, m); const size_t r = (size_t)ri;
                const int v = ri < NPROMPT ? 0 : 1 + ((ri - NPROMPT) >> 10);
                const size_t xo = ri < NPROMPT ? r * DM : (r - NPROMPT) * DM; const void* Xb = ri < NPROMPT ? Xp : Xs;
                const float* gp = mod + v * 12288 + goff;
#pragma unroll
                for (int bj = 0; bj < 2; ++bj) { const int c = col0 + bj * 128;
                    const f32x4 g0 = *(const f32x4*)(gp + c), g1 = *(const f32x4*)(gp + c + 4);
                    f32x4 x0, x1;
                    if (XBF) unpack8(*(const u32x4*)((const bf16_t*)Xb + xo + c), x0, x1);
                    else { x0 = *(const f32x4*)((const float*)Xb + xo + c); x1 = *(const f32x4*)((const float*)Xb + xo + c + 4); }
                    const f32x4 o0 = x0 + g0 * acc[ai][bj][m][0], o1 = x1 + g1 * acc[ai][bj][m][1];
                    if (OBF) *(u32x4*)((bf16_t*)O + r * DM + c) = pack8(o0, o1);
                    else { *(f32x4*)((float*)O + r * DM + c) = o0; *(f32x4*)((float*)O + r * DM + c + 4) = o1; } } }
    }
};
struct EpiUp {
    bf16_t* U;
    __device__ __forceinline__ void operator()(const AccT& acc, const Unit& u, int wr, int wc, int fr, int fq) const {
        const int row0 = u.pm * 256 + wr * 64 + fr, col0 = u.pn * 256 + wc * 32 + 8 * fq;
#pragma unroll
        for (int ai = 0; ai < 2; ++ai)
#pragma unroll
            for (int m = 0; m < 4; ++m) { const size_t r = (size_t)(row0 + ai * 128 + m * 16);
#pragma unroll
                for (int bj = 0; bj < 2; ++bj) { f32x4 a = acc[ai][bj][m][0], b = acc[ai][bj][m][1];
#pragma unroll
                    for (int j = 0; j < 4; ++j) { a[j] = fmaxf(a[j], 0.f); a[j] *= a[j]; b[j] = fmaxf(b[j], 0.f); b[j] *= b[j]; }
                    *(u32x4*)(U + r * DFF + col0 + bj * 128) = pack8(a, b); } }
    }
};

constexpr int SHM_V = 64 * 128 * 2, SHM_K = 64 * 128 * 2;
constexpr int ATT_WS_OFF = 2 * SHM_V + 2 * SHM_K, ATT_TBL_OFF = ATT_WS_OFF + 8 * 64 * 4, TBL_PAD = 64;
constexpr float THR2 = 8.f * LOG2E;
#define KSWZ(row, colB) ((row) * 256 + ((colB) ^ (((row) & 7) << 4)))
#define SBAR() __builtin_amdgcn_sched_barrier(0)
__device__ __forceinline__ int crow(int r, int hi) { return (r & 3) + 8 * (r >> 2) + 4 * hi; }

struct MaskCtx { int mode, nctx, loc0, qw0, r32, hi; const float* tbl; };

__device__ __forceinline__ void xform(f32x16& p0, f32x16& p1, const MaskCtx& mc, int j) {
    constexpr float C = SM_SCALE * LOG2E;
    if (j >= mc.nctx && mc.mode != 0) {
        const int kpos0 = mc.loc0 + (j - mc.nctx) * 64;
        if (mc.mode == 1) {
            const bool need = (kpos0 + 63 - mc.qw0 > 128) || (mc.qw0 + 31 - kpos0 > 128);
            if (need) {
                const int d0 = kpos0 - (mc.qw0 + mc.r32) + 128 + 4 * mc.hi;
#pragma unroll
                for (int r = 0; r < 16; ++r) { const int kc = (r & 3) + 8 * (r >> 2);
                    p0[r] = ((unsigned)(d0 + kc) <= 256u) ? p0[r] * C : NEGBIG;
                    p1[r] = ((unsigned)(d0 + 32 + kc) <= 256u) ? p1[r] * C : NEGBIG; }
                return;
            }
        } else {
            const int rk = kpos0 >> 6, rq = mc.qw0 >> 6; const int rstart = min(max(rq - 4, 0), 8);
            if ((unsigned)(rk - rstart) >= 8u) {
#pragma unroll
                for (int r = 0; r < 16; ++r) { p0[r] = NEGBIG; p1[r] = NEGBIG; }
                return;
            }
            const int cq = (mc.qw0 & 63) + mc.r32; const int cstart = min(max(cq - 8, 0), 48);
            const int e0 = 4 * mc.hi - cstart;
            const float* tb = mc.tbl + (TBL_PAD + (rk - rq + 7) * 31 - cq + 15 + 4 * mc.hi);
#pragma unroll
            for (int r = 0; r < 16; ++r) { const int kc = (r & 3) + 8 * (r >> 2);
                const float b0 = tb[kc], b1 = tb[kc + 32];
                p0[r] = ((unsigned)(e0 + kc) < 16u) ? fmaf(p0[r], C, b0) : NEGBIG;
                p1[r] = ((unsigned)(e0 + 32 + kc) < 16u) ? fmaf(p1[r], C, b1) : NEGBIG; }
            return;
        }
    }
#pragma unroll
    for (int r = 0; r < 16; ++r) { p0[r] *= C; p1[r] *= C; }
}
__device__ __forceinline__ void partialSM(f32x16& p0, f32x16& p1, float& m_reg, float& mn, float& alpha, const MaskCtx& mc, int j) {
    xform(p0, p1, mc, j);
    float pmax = p0[0];
#pragma unroll
    for (int r = 1; r < 16; ++r) pmax = fmaxf(pmax, p0[r]);
#pragma unroll
    for (int r = 0; r < 16; ++r) pmax = fmaxf(pmax, p1[r]);
    { auto rr = __builtin_amdgcn_permlane32_swap(__float_as_uint(pmax), __float_as_uint(pmax), false, false);
      pmax = fmaxf(__uint_as_float(rr[0]), __uint_as_float(rr[1])); }
    if (__builtin_expect(__all(pmax - m_reg <= THR2), 1)) { mn = m_reg; alpha = 1.f; }
    else { mn = fmaxf(m_reg, pmax); alpha = __builtin_amdgcn_exp2f(m_reg - mn); m_reg = mn; }
#pragma unroll
    for (int r = 0; r < 16; ++r) { p0[r] -= mn; p1[r] -= mn; }
#pragma unroll
    for (int r = 0; r < 16; ++r) p0[r] = __builtin_amdgcn_exp2f(p0[r]);
}
__device__ __forceinline__ void finishSM(f32x16& p0, f32x16& p1, float alpha, float& l_reg, bf16x8& pa0, bf16x8& pa1, bf16x8& pa2, bf16x8& pa3) {
#pragma unroll
    for (int r = 0; r < 16; ++r) p1[r] = __builtin_amdgcn_exp2f(p1[r]);
    float ps = 0;
#pragma unroll
    for (int r = 0; r < 16; ++r) ps += p0[r];
#pragma unroll
    for (int r = 0; r < 16; ++r) ps += p1[r];
    { auto rr = __builtin_amdgcn_permlane32_swap(__float_as_uint(ps), __float_as_uint(ps), false, false);
      ps = __uint_as_float(rr[0]) + __uint_as_float(rr[1]); }
    l_reg = l_reg * alpha + ps;
#define PK4(P, BASE, OUT) do { unsigned a0 = cvtpk(P[BASE + 0], P[BASE + 1]), a1 = cvtpk(P[BASE + 2], P[BASE + 3]);   \
    unsigned b0 = cvtpk(P[BASE + 4], P[BASE + 5]), b1 = cvtpk(P[BASE + 6], P[BASE + 7]);                              \
    auto r0 = __builtin_amdgcn_permlane32_swap(a0, b0, false, false); auto r1 = __builtin_amdgcn_permlane32_swap(a1, b1, false, false); \
    u32x4 w = {r0[0], r1[0], r0[1], r1[1]}; OUT = *reinterpret_cast<bf16x8*>(&w); } while (0)
    PK4(p0, 0, pa0); PK4(p0, 8, pa1); PK4(p1, 0, pa2); PK4(p1, 8, pa3);
#undef PK4
}
__device__ __forceinline__ void qkt(f32x16& p0, f32x16& p1, const char* Ks, const bf16x8* qr, int r32, int hi) {
    p0 = f32x16{}; p1 = f32x16{};
#pragma unroll
    for (int d0 = 0; d0 < 8; ++d0) { const int cb = (d0 * 16 + hi * 8) * 2;
        bf16x8 b0 = *reinterpret_cast<const bf16x8*>(Ks + KSWZ(r32, cb));
        bf16x8 b1 = *reinterpret_cast<const bf16x8*>(Ks + KSWZ(32 + r32, cb));
        p0 = __builtin_amdgcn_mfma_f32_32x32x16_bf16(b0, qr[d0], p0, 0, 0, 0);
        p1 = __builtin_amdgcn_mfma_f32_32x32x16_bf16(b1, qr[d0], p1, 0, 0, 0); }
}
__device__ __forceinline__ int v_st(int k, int c) { const int kk = (k & ~0xC) | ((k & 4) << 1) | ((k & 8) >> 1); return ((kk >> 3) * 4 + (c >> 5)) * 512 + ((kk & 7) * 32 + (c & 31)) * 2; }
__device__ __forceinline__ int v_rd_base(int lane) { return ((lane & 3) << 3) | (((lane >> 2) & 3) << 6) | (((lane >> 4) & 1) << 5) | (((lane >> 5) & 1) << 8); }
constexpr int v_rd_off(int d0, int ks, int half) { return d0 * 512 + ks * 4096 + half * 2048; }
template <int OFF> __device__ __forceinline__ s16x4 tr_read(int vb) {
    s16x4 r; asm volatile("ds_read_b64_tr_b16 %0, %1 offset:%2" : "=&v"(r) : "v"(vb), "i"(OFF) : "memory"); return r;
}
template <int D0> __device__ __forceinline__ void pv_one(f32x16& od, int vb, bf16x8 pa0, bf16x8 pa1, bf16x8 pa2, bf16x8 pa3) {
    const s16x4 l0 = tr_read<v_rd_off(D0, 0, 0)>(vb), h0 = tr_read<v_rd_off(D0, 0, 1)>(vb), l1 = tr_read<v_rd_off(D0, 1, 0)>(vb), h1 = tr_read<v_rd_off(D0, 1, 1)>(vb);
    const s16x4 l2 = tr_read<v_rd_off(D0, 2, 0)>(vb), h2 = tr_read<v_rd_off(D0, 2, 1)>(vb), l3 = tr_read<v_rd_off(D0, 3, 0)>(vb), h3 = tr_read<v_rd_off(D0, 3, 1)>(vb);
    asm volatile("s_waitcnt lgkmcnt(0)" ::: "memory"); SBAR();
#define PK(L, H) (bf16x8){L[0], L[1], L[2], L[3], H[0], H[1], H[2], H[3]}
    od = __builtin_amdgcn_mfma_f32_32x32x16_bf16(pa0, PK(l0, h0), od, 0, 0, 0);
    od = __builtin_amdgcn_mfma_f32_32x32x16_bf16(pa1, PK(l1, h1), od, 0, 0, 0);
    od = __builtin_amdgcn_mfma_f32_32x32x16_bf16(pa2, PK(l2, h2), od, 0, 0, 0);
    od = __builtin_amdgcn_mfma_f32_32x32x16_bf16(pa3, PK(l3, h3), od, 0, 0, 0);
#undef PK
}
__device__ __forceinline__ void pv_d0(f32x16* o, int vb, bf16x8 pa0, bf16x8 pa1, bf16x8 pa2, bf16x8 pa3) {
    pv_one<0>(o[0], vb, pa0, pa1, pa2, pa3); pv_one<1>(o[1], vb, pa0, pa1, pa2, pa3); pv_one<2>(o[2], vb, pa0, pa1, pa2, pa3); pv_one<3>(o[3], vb, pa0, pa1, pa2, pa3);
}

__device__ __forceinline__ void attn_item(const bf16_t* Qb, const bf16_t* Kl, const bf16_t* Vl, const bf16_t* Kc, const bf16_t* Vc, bf16_t* Ob,
                                          int LDK, int nctx, int loc0, int NT, int mode, int qbase, bool has_sink, float sink2, const float* rpb_h, char* lds) {
    int tid_ = threadIdx.x; asm volatile("" : "+v"(tid_));
    const int tid = tid_, wid = tid >> 6, lane = tid & 63, r32 = lane & 31, hi = lane >> 5;
    char* V_lds = lds; char* K_lds = lds + 2 * SHM_V;
    float* wsf = (float*)(lds + ATT_WS_OFF) + wid * 64; float* li_l = wsf; float* al_l = wsf + 32;
    float* tbl = (float*)(lds + ATT_TBL_OFF);
    __syncthreads();
    if (mode == 2) { for (int e = tid; e < 465; e += 512) tbl[TBL_PAD + e] = rpb_h[e] * LOG2E; }
    MaskCtx mc; mc.mode = mode; mc.nctx = nctx; mc.loc0 = loc0; mc.qw0 = qbase + wid * 32; mc.r32 = r32; mc.hi = hi; mc.tbl = tbl;
    float m_reg = -1e30f, l_reg = 0; f32x16 o[4] = {}; bf16x8 qr[8];
    const bf16_t* Qw = Qb + (size_t)(wid * 32 + r32) * 1024 + hi * 8;
#pragma unroll
    for (int d0 = 0; d0 < 8; ++d0) qr[d0] = *reinterpret_cast<const bf16x8*>(Qw + d0 * 16);
    const int sr = tid >> 4, sc = (tid & 15) * 8, vst0 = v_st(sr, sc), vst1 = v_st(32 + sr, sc);
    const int off0 = sr * LDK + sc, off1 = (32 + sr) * LDK + sc;
    const int vb0 = (int)(uintptr_t)(LAS char*)V_lds + v_rd_base(lane);
    bf16x8 sv0, sv1, sk0, sk1;
#define TILEK(j) ((j) < nctx ? Kc + (size_t)(j) * 64 * LDK : Kl + (size_t)(loc0 + ((j) - nctx) * 64) * LDK)
#define TILEV(j) ((j) < nctx ? Vc + (size_t)(j) * 64 * LDK : Vl + (size_t)(loc0 + ((j) - nctx) * 64) * LDK)
#define SLOAD(j) do { const bf16_t* _k = TILEK(j); const bf16_t* _v = TILEV(j); \
    sv0 = *reinterpret_cast<const bf16x8*>(_v + off0); sv1 = *reinterpret_cast<const bf16x8*>(_v + off1); \
    sk0 = *reinterpret_cast<const bf16x8*>(_k + off0); sk1 = *reinterpret_cast<const bf16x8*>(_k + off1); } while (0)
#define SWRITE(b) do { *(bf16x8*)(V_lds + (b) * SHM_V + vst0) = sv0; *(bf16x8*)(V_lds + (b) * SHM_V + vst1) = sv1; const int kc_ = sc * 2; \
    *(bf16x8*)(K_lds + (b) * SHM_K + KSWZ(sr, kc_)) = sk0; *(bf16x8*)(K_lds + (b) * SHM_K + KSWZ(32 + sr, kc_)) = sk1; } while (0)
#define RESC(a) do { if (__any((a) < 1.f)) { if (hi == 0) al_l[r32] = (a); asm volatile("s_waitcnt lgkmcnt(0)" ::: "memory"); \
    _Pragma("unroll") for (int d = 0; d < 4; ++d) _Pragma("unroll") for (int r = 0; r < 16; ++r) o[d][r] *= al_l[crow(r, hi)]; } } while (0)
    SLOAD(0); SWRITE(0); if (NT > 1) SLOAD(1);
    __syncthreads();
    for (int j = 0; j < NT; ++j) {
        const int bo = j & 1;
        if (j + 1 < NT) { SWRITE(bo ^ 1); if (j + 2 < NT) SLOAD(j + 2); }
        f32x16 p0, p1; float mn, al; bf16x8 pa0, pa1, pa2, pa3;
        SBAR(); qkt(p0, p1, K_lds + bo * SHM_K, qr, r32, hi);
        partialSM(p0, p1, m_reg, mn, al, mc, j);
        RESC(al);
        finishSM(p0, p1, al, l_reg, pa0, pa1, pa2, pa3); SBAR();
        pv_d0(o, vb0 + bo * SHM_V, pa0, pa1, pa2, pa3);
        __syncthreads();
    }
    if (has_sink) l_reg += __builtin_amdgcn_exp2f(sink2 - m_reg);
    if (hi == 0) li_l[r32] = l_reg; asm volatile("s_waitcnt lgkmcnt(0)" ::: "memory");
    float rli[16];
#pragma unroll
    for (int r = 0; r < 16; ++r) rli[r] = __builtin_amdgcn_rcpf(li_l[crow(r, hi)]);
    bf16_t* Ow = Ob + (size_t)(wid * 32) * 2048;
#pragma unroll
    for (int r = 0; r < 16; ++r) { const int orow = crow(r, hi);
#pragma unroll
        for (int d0 = 0; d0 < 4; ++d0) Ow[(size_t)orow * 2048 + d0 * 32 + r32] = f2bf(o[d0][r] * rli[r]); }
#undef TILEK
#undef TILEV
#undef SLOAD
#undef SWRITE
#undef RESC
}


__device__ __forceinline__ void transpose_item(const Params& p, int t, int tid, char* shm) {
    char* ws = p.ws; const float* W; bf16_t* WT; int N, ldk, koff = 0;
    if (t < 4352) { W = p.w_in; WT = (bf16_t*)(ws + WS_WIN); ldk = 2048; N = INW; }
    else if (t < 4864) { t -= 4352; W = p.w_br_a; WT = (bf16_t*)(ws + WS_WBRA); ldk = 2048; N = 2048; }
    else if (t < 5376) { t -= 4864; W = p.w_br_b; WT = (bf16_t*)(ws + WS_WBRA); ldk = 2048; N = 2048; koff = 1024; }
    else if (t < 6400) { t -= 5376; W = p.w_out; WT = (bf16_t*)(ws + WS_WOUT); ldk = 2048; N = 2048; }
    else if (t < 10496) { t -= 6400; W = p.w_up; WT = (bf16_t*)(ws + WS_WUP); ldk = 2048; N = DFF; }
    else { t -= 10496; W = p.w_down; WT = (bf16_t*)(ws + WS_WDOWN); ldk = DFF; N = 2048; }
    const int nN = N >> 6; const int tn = t % nN, tk = t / nN; const int k0 = tk * 64, n0 = tn * 64;
    bf16_t* T = (bf16_t*)shm;
    const int kq = tid >> 6, c4 = tid & 63;
    f32x4 v[8];
#pragma unroll
    for (int i = 0; i < 8; ++i) v[i] = __builtin_nontemporal_load((const f32x4*)(W + (size_t)(k0 + 8 * kq + i) * N + n0 + c4 * 4));
#pragma unroll
    for (int j = 0; j < 4; ++j) {
        const u32x4 w = {cvtpk(v[0][j], v[1][j]), cvtpk(v[2][j], v[3][j]), cvtpk(v[4][j], v[5][j]), cvtpk(v[6][j], v[7][j])};
        *(u32x4*)(T + (j * 64 + c4) * 72 + kq * 8) = w; }
    __syncthreads();
#pragma unroll
    for (int q = 0; q < 4; ++q) { const int n = (tid >> 3) + 64 * q, kc = tid & 7;
        *(u32x4*)(WT + (size_t)(n0 + n) * ldk + koff + k0 + kc * 8) = *(const u32x4*)(T + ((n & 3) * 64 + (n >> 2)) * 72 + kc * 8); }
    __syncthreads();
}

#ifndef DUP_PHASE
#define DUP_PHASE -1
#endif
#define REP(n) for (int rep_ = 0; rep_ < ((n) == DUP_PHASE ? 2 : 1); ++rep_)
#define W_DOWN_PART(h) do { const int nt_ = (MTOK / 256) * (DM / 256); int tid_ = threadIdx.x; asm volatile("" : "+v"(tid_)); \
    (void)nt_; for (int it = blockIdx.x; it < 512; it += gridDim.x) transpose_item(p, 10496 + ((h) * 512 + it) * 4, tid_, shm); } while (0)
#define PHASE_ON(n) (p.ph_lo <= (n) && (n) <= p.ph_hi)
#define XB_TMO      128
#define XB_XCNT(j)  (256  + 64 * (j))
#define XB_XSUB(j)  (1280 + 64 * (j))
#define XB_XGEN(j)  (2304 + 64 * (j))
#define XB_TOP      3328
#define XB_TOPGEN   3392
#define XCD_BAR_WORDS 3456
#define XB_SPIN_CAP (1u << 20)
__device__ __forceinline__ unsigned xb_ld(unsigned* q)              { return __hip_atomic_load(q, __ATOMIC_RELAXED, __HIP_MEMORY_SCOPE_AGENT); }
__device__ __forceinline__ unsigned xb_add(unsigned* q, unsigned v) { return __hip_atomic_fetch_add(q, v, __ATOMIC_RELAXED, __HIP_MEMORY_SCOPE_AGENT); }
__device__ __forceinline__ unsigned xb_xcc_id() { return (unsigned)__builtin_amdgcn_s_getreg((3 << 11) | 20) & 0xFu; }
#define XB_SPIN(cond, bar) do { unsigned _sp = 0; while (cond) { __builtin_amdgcn_s_sleep(1); \
    if ((++_sp & 255u) == 0u) { if (xb_ld(&(bar)[XB_TMO])) break; if (_sp > XB_SPIN_CAP) { atomicAdd(&(bar)[XB_TMO], 1u); break; } } } } while (0)
__device__ __forceinline__ void xcd_barrier_complete(unsigned* bar, unsigned x, unsigned& nloc, unsigned& nx) {
    const unsigned G = gridDim.x;
    unsigned sum, cnt, mine, sp = 0u;
    for (;;) {
        sum = 0u; cnt = 0u; mine = 0u;
#pragma unroll
        for (unsigned j = 0; j < 16; ++j) { const unsigned c = xb_ld(&bar[XB_XCNT(j)]); sum += c; cnt += (c > 0u) ? 1u : 0u; mine = (j == x) ? c : mine; }
        if (sum == G) break;
        __builtin_amdgcn_s_sleep(1);
        if ((++sp & 255u) == 0u) { if (xb_ld(&bar[XB_TMO])) break; if (sp > XB_SPIN_CAP) { atomicAdd(&bar[XB_TMO], 1u); break; } }
    }
    nloc = mine > 0u ? mine : 1u; nx = cnt > 0u ? cnt : 1u;
}
__device__ __forceinline__ void xcd_barrier(unsigned* bar, unsigned x, volatile LAS unsigned* st) {
    asm volatile("s_waitcnt vmcnt(0)" ::: "memory");
    __syncthreads();
    if (threadIdx.x == 0) {
        __builtin_amdgcn_s_waitcnt(0);
        unsigned nloc = st[0], nx = st[1];
        if (nloc == 0u) { xcd_barrier_complete(bar, x, nloc, nx); st[0] = nloc; st[1] = nx; }
        const unsigned old = xb_add(&bar[XB_XSUB(x)], 1u);
        const unsigned gen = old / nloc;
        if (old + 1u == (gen + 1u) * nloc) {
            __builtin_amdgcn_fence(__ATOMIC_RELEASE, "agent");
            asm volatile("s_waitcnt vmcnt(0)" ::: "memory");
            const unsigned og = xb_add(&bar[XB_TOP], 1u);
            const unsigned tg = og / nx;
            if (og + 1u == (tg + 1u) * nx) xb_add(&bar[XB_TOPGEN], 1u);
            else XB_SPIN(xb_ld(&bar[XB_TOPGEN]) == tg, bar);
            __builtin_amdgcn_fence(__ATOMIC_ACQUIRE, "agent");
            xb_add(&bar[XB_XGEN(x)], 1u);
            asm volatile("s_waitcnt vmcnt(0)" ::: "memory");
        } else {
            XB_SPIN(xb_ld(&bar[XB_XGEN(x)]) == gen, bar);
            __builtin_amdgcn_fence(__ATOMIC_ACQUIRE, "agent");
            asm volatile("s_waitcnt vmcnt(0)" ::: "memory");
        }
    }
    __syncthreads();
}
#define GRID_SYNC() xcd_barrier(gbar, xcc_, xst_)
#define PHASE_SYNC(n) do { if (p.ph_lo < (n) && (n) <= p.ph_hi) GRID_SYNC(); } while (0)
__global__ void __launch_bounds__(512) fwd_megakernel(Params p) {
    extern __shared__ __attribute__((aligned(16))) char shm[];
    cg::grid_group grid = cg::this_grid();
    if (p.ph_lo > 1000) grid.sync();
    unsigned* gbar = (unsigned*)(p.ws + WS_BAR);
    volatile LAS unsigned* xst_ = (volatile LAS unsigned*)(LAS char*)(shm + LDS_BYTES - 16);
    if (threadIdx.x == 0) { xst_[0] = 0u; xst_[1] = 0u; }
    __syncthreads();
    const unsigned xcc_ = xb_xcc_id();
    if (threadIdx.x == 0) (void)xb_add(&gbar[XB_XCNT(xcc_)], 1u);
    char* ws = p.ws;
    bf16_t* WinT = (bf16_t*)(ws + WS_WIN); bf16_t* WbrT = (bf16_t*)(ws + WS_WBRA);
    bf16_t* WoutT = (bf16_t*)(ws + WS_WOUT); bf16_t* WupT = (bf16_t*)(ws + WS_WUP); bf16_t* WdownT = (bf16_t*)(ws + WS_WDOWN);
    bf16_t* Hb = (bf16_t*)(ws + WS_H);
    bf16_t* Ob = (bf16_t*)(ws + WS_P + (size_t)MTOK * DM * 4);
    bf16_t* X1 = (bf16_t*)(ws + WS_P);
    bf16_t* QA = (bf16_t*)(ws + WS_QK); bf16_t* KA = QA + (size_t)MTOK * 1024; bf16_t* QB = KA + (size_t)MTOK * 256; bf16_t* KB = QB + (size_t)MTOK * 1024;
    bf16_t* VA = (bf16_t*)(ws + WS_V); bf16_t* VB = VA + (size_t)MTOK * 256;
    bf16_t* Gt = (bf16_t*)(ws + WS_G); bf16_t* Ub = (bf16_t*)(ws + WS_QK);
    bf16_t* Mb = (bf16_t*)(ws + WS_M);
    bf16_t* CAK = (bf16_t*)(ws + WS_CTX); bf16_t* CAV = CAK + 131072; bf16_t* CBK = CAV + 131072; bf16_t* CBV = CBK + 524288;
    float* mod = (float*)(ws + WS_MOD); float* ropeC = (float*)(ws + WS_ROPE); float* ropeS = ropeC + 2048;

    if (PHASE_ON(0)) REP(0) {
        int tid_ = threadIdx.x; asm volatile("" : "+v"(tid_)); const int tid = tid_, wid = tid >> 6, lane = tid & 63;
        constexpr int NGEMV = 192, NTR = 576;
#define WIN_QKV_ITEM(j) ((((j) / 18) * 34 + ((j) % 18)) * 4)
#define WIN_GATE_ITEM(j) ((((j) / 16) * 34 + 18 + ((j) % 16)) * 4)
        const int G = gridDim.x, bx = blockIdx.x;
        if (bx < NGEMV) {
            for (int s = bx; s < NGEMV; s += G) {
                float* red = (float*)shm;
                float* sil = (float*)shm + 2048;
                for (int e = tid; e < 6144; e += 512) { const int v = e >> 11, k = e & 2047; const float c = v == 0 ? p.c_ctx[k] : p.c[(v - 1) * 2048 + k]; sil[e] = c * sigmoidf_(c); }
                __syncthreads();
                const int kb = __builtin_amdgcn_readfirstlane(wid) * 256;
                const float* wp = p.w_ada + (size_t)kb * 12288 + s * 64 + lane;
                float a0 = 0.f, a1 = 0.f, a2 = 0.f;
#pragma unroll 32
                for (int i = 0; i < 256; ++i) {
                    const float w = __builtin_nontemporal_load(wp + (size_t)i * 12288);
                    a0 += sil[kb + i] * w; a1 += sil[2048 + kb + i] * w; a2 += sil[4096 + kb + i] * w;
                }
                red[(wid * 3 + 0) * 64 + lane] = a0; red[(wid * 3 + 1) * 64 + lane] = a1; red[(wid * 3 + 2) * 64 + lane] = a2;
                __syncthreads();
                if (tid < 192) { const int v = tid >> 6, col = tid & 63; const int n = s * 64 + col; float sum = p.b_ada[n];
#pragma unroll
                    for (int w = 0; w < 8; ++w) sum += red[(w * 3 + v) * 64 + col];
                    mod[v * 12288 + n] = sum; }
                __syncthreads();
            }
        }
        if (G > NGEMV) {
            if (bx >= NGEMV) { for (int it = bx - NGEMV; it < 256; it += G - NGEMV) transpose_item(p, WIN_QKV_ITEM(it), tid, shm); }
            else { for (int it = 256 + bx; it < NTR; it += NGEMV) transpose_item(p, WIN_QKV_ITEM(it), tid, shm); }
        } else { for (int it = bx; it < NTR; it += G) transpose_item(p, WIN_QKV_ITEM(it), tid, shm); }
        for (int i = blockIdx.x * 512 + tid; i < 327680; i += gridDim.x * 512) {
            const float* src; bf16_t* dst; int j = i;
            if (j < 32768) { src = p.cak; dst = CAK; } else if (j < 65536) { j -= 32768; src = p.cav; dst = CAV; }
            else if (j < 196608) { j -= 65536; src = p.cbk; dst = CBK; } else { j -= 196608; src = p.cbv; dst = CBV; }
            const f32x4 v = *(const f32x4*)(src + (size_t)j * 4);
            *(u32x2*)(dst + (size_t)j * 4) = (u32x2){cvtpk(v[0], v[1]), cvtpk(v[2], v[3])};
        }
        if (blockIdx.x == gridDim.x - 1) {
            for (int e = tid; e < 2048; e += 512) { const int pos = e >> 5, i = e & 31;
                const float inv = exp2f(-(float)i * (13.287712379549449f / 32.f));
                const float ang = (float)pos * inv;
                ropeC[e] = cosf(ang); ropeS[e] = sinf(ang); }
            float* normw = (float*)(ws + WS_NORMW);
            { const int e = tid; normw[e] = e < 128 ? p.qna[e] : e < 256 ? p.kna[e - 128] : e < 384 ? p.qnb[e - 256] : p.knb[e - 384]; }
        }
    }
    PHASE_SYNC(1);
#define NORM_PHASE(FIRST) do { \
        int tid_ = threadIdx.x; asm volatile("" : "+v"(tid_)); const int wid = tid_ >> 6, lane = tid_ & 63; \
        const float* nwp = (FIRST) ? p.norm1_w : p.norm2_w; const int shoff = (FIRST) ? 0 : 6144, scoff = (FIRST) ? 2048 : 8192; \
        for (int row = blockIdx.x * 8 + wid; row < MTOK; row += gridDim.x * 8) { \
            const float* xr = row < NPROMPT ? p.x_prompt + (size_t)row * DM : p.x_sample + (size_t)(row - NPROMPT) * DM; const bf16_t* xb = X1 + (size_t)row * DM; \
            const int v = row < NPROMPT ? 0 : 1 + ((row - NPROMPT) >> 10); \
            const float* md = mod + v * 12288; \
            f32x4 xv[8]; float ss = 0; \
            _Pragma("unroll") for (int i = 0; i < 8; ++i) { if (FIRST) xv[i] = __builtin_nontemporal_load((const f32x4*)(xr + (i * 64 + lane) * 4)); else { const u32x2 w_ = *(const u32x2*)(xb + (i * 64 + lane) * 4); xv[i] = (f32x4){__uint_as_float(w_[0] << 16), __uint_as_float(w_[0] & 0xffff0000u), __uint_as_float(w_[1] << 16), __uint_as_float(w_[1] & 0xffff0000u)}; } ss += xv[i][0] * xv[i][0] + xv[i][1] * xv[i][1] + xv[i][2] * xv[i][2] + xv[i][3] * xv[i][3]; } \
            ss = wave_sum(ss); \
            const float rstd = rsqrtf(ss * (1.f / 2048.f) + 1e-6f); \
            _Pragma("unroll") for (int i = 0; i < 8; ++i) { const int c = (i * 64 + lane) * 4; \
                const f32x4 nw = *(const f32x4*)(nwp + c), sc = *(const f32x4*)(md + scoff + c), sh = *(const f32x4*)(md + shoff + c); \
                f32x4 h; \
                _Pragma("unroll") for (int j = 0; j < 4; ++j) h[j] = (xv[i][j] * rstd * nw[j]) * (1.f + sc[j]) + sh[j]; \
                *(u32x2*)(Hb + (size_t)row * DM + c) = (u32x2){cvtpk(h[0], h[1]), cvtpk(h[2], h[3])}; } \
        } } while (0)
    if (PHASE_ON(1)) REP(1) NORM_PHASE(true);
    PHASE_SYNC(2);
    if (PHASE_ON(2)) REP(2) {
        pg8::StaticOrder S; S.init(MTOK, 4608, gridDim.x, blockIdx.x);
        Epi1 E{ws, p.out, (float*)(shm + 131072)};
        pg8::gemm_phase((LAS unsigned char*)shm, pg8::Gemm{Hb, WinT, MTOK, 4608, DM, DM}, S, E);
        const int nfour = (MTOK / 256) * (4608 / 256) - 1 * (int)gridDim.x;
        if (nfour > 0 && nfour < (int)gridDim.x) {
            if ((int)blockIdx.x >= nfour) { int tid_ = threadIdx.x; asm volatile("" : "+v"(tid_));
                for (int it = blockIdx.x - nfour; it < 1024; it += gridDim.x - nfour) transpose_item(p, 6400 + it * 4, tid_, shm);
                for (int it = blockIdx.x - nfour; it < 512; it += gridDim.x - nfour) transpose_item(p, WIN_GATE_ITEM(it), tid_, shm); }
        } else { int tid_ = threadIdx.x; asm volatile("" : "+v"(tid_));
            for (int it = blockIdx.x; it < 1024; it += gridDim.x) transpose_item(p, 6400 + it * 4, tid_, shm);
            for (int it = blockIdx.x; it < 512; it += gridDim.x) transpose_item(p, WIN_GATE_ITEM(it), tid_, shm); }
    }
    PHASE_SYNC(3);
    if (PHASE_ON(3)) REP(3) {
        int tid_ = threadIdx.x; asm volatile("" : "+v"(tid_)); const int wid = tid_ >> 6, lane = tid_ & 63;
        for (int row = NPROMPT + blockIdx.x * 8 + wid; row < MTOK; row += gridDim.x * 8) {
            const int t = (row - NPROMPT) & 1023; const int gr = t >> 6, gc = t & 63; const int fi = lane & 31;
            const float c0 = ropeC[gr * 32 + fi], s0 = ropeS[gr * 32 + fi], c1 = ropeC[gc * 32 + fi], s1 = ropeS[gc * 32 + fi];
#pragma unroll
            for (int hv = 0; hv < 10; ++hv) {
                bf16_t* d = hv < 8 ? QA + (size_t)row * 1024 + hv * 128 : KA + (size_t)row * 256 + (hv - 8) * 128;
                float a = __uint_as_float(((unsigned)d[lane]) << 16), b = __uint_as_float(((unsigned)d[64 + lane]) << 16);
                const float pa = __shfl_xor(a, 32), pb = __shfl_xor(b, 32);
                if (lane < 32) { a = a * c0 - pa * s0; b = b * c1 - pb * s1; }
                else { a = pa * s0 + a * c0; b = pb * s1 + b * c1; }
                d[lane] = f2bf(a); d[64 + lane] = f2bf(b);
            }
        }
    }
    PHASE_SYNC(4);
    if (PHASE_ON(4)) REP(4) {
        { pg8::StaticOrder S; S.init(MTOK, 4096, gridDim.x, blockIdx.x);
          EpiGate E{Gt};
          pg8::gemm_phase((LAS unsigned char*)shm, pg8::Gemm{Hb, WinT + (size_t)4608 * DM, MTOK, 4096, DM, DM}, S, E); }
        const int abx = ((int)gridDim.x == 256) ? ((int)blockIdx.x ^ 128) : (int)blockIdx.x;
        for (int slot = abx; slot < 512; slot += gridDim.x) {
            const bf16_t *Qp, *Kl, *Vl, *Kc, *Vc; bf16_t* Op; int LDK, nctx, loc0, NT, mode, qbase, h; bool isA;
            if (slot < 64) {
                const int b = (slot >> 3) & 1, g = slot >> 4; h = slot & 7; const size_t rb = NPROMPT + (size_t)b * 1024; isA = false;
                loc0 = (g < 2 ? 0 : (g == 2 ? 4 : 8)) * 64; NT = 4 + ((g == 0 || g == 3) ? 8 : 12); nctx = 4; mode = 2; qbase = 256 * g; LDK = 1024;
                Qp = QB + (rb + 256 * g) * 1024 + h * 128; Kl = KB + rb * 1024 + h * 128; Vl = VB + rb * 1024 + h * 128;
                Kc = CBK + (size_t)b * 262144 + h * 128; Vc = CBV + (size_t)b * 262144 + h * 128; Op = Ob + (rb + 256 * g) * 2048 + 1024 + h * 128;
            } else if (slot < 128) {
                const int s = slot - 64; const int b = (s >> 3) & 1, cch = s >> 4; h = s & 7; const size_t rb = NPROMPT + (size_t)b * 1024; isA = true;
                loc0 = max(0, 256 * cch - 128); const int lend = min(1024, 256 * cch + 384); NT = 4 + (lend - loc0) / 64; nctx = 4; mode = 1; qbase = 256 * cch; LDK = 256;
                Qp = QA + (rb + 256 * cch) * 1024 + h * 128; Kl = KA + rb * 256 + (h >> 2) * 128; Vl = VA + rb * 256 + (h >> 2) * 128;
                Kc = CAK + (size_t)b * 65536 + (h >> 2) * 128; Vc = CAV + (size_t)b * 65536 + (h >> 2) * 128; Op = Ob + (rb + 256 * cch) * 2048 + h * 128;
            } else {
                int pi;
                if (slot < 256) pi = slot - 128; else if (slot >= 384) pi = slot - 256; else continue;
                isA = pi < 128; if (!isA) pi -= 128;
                const int b = pi >> 3; h = pi & 7; const size_t rb = (size_t)b * 256;
                loc0 = 0; NT = 4; nctx = 0; mode = 0; qbase = 0;
                if (isA) { LDK = 256; Qp = QA + rb * 1024 + h * 128; Kl = KA + rb * 256 + (h >> 2) * 128; Vl = VA + rb * 256 + (h >> 2) * 128; Op = Ob + rb * 2048 + h * 128; }
                else { LDK = 1024; Qp = QB + rb * 1024 + h * 128; Kl = KB + rb * 1024 + h * 128; Vl = VB + rb * 1024 + h * 128; Op = Ob + rb * 2048 + 1024 + h * 128; }
                Kc = Kl; Vc = Vl;
            }
            attn_item(Qp, Kl, Vl, Kc, Vc, Op, LDK, nctx, loc0, NT, mode, qbase, isA, isA ? p.sink_a[h] * LOG2E : 0.f, p.rpb + h * 465, shm);
        }
        { const int nheavy = gridDim.x >> 1; int tid_ = threadIdx.x; asm volatile("" : "+v"(tid_));
          __syncthreads();
          if (abx < nheavy) for (int it = abx; it < 512; it += nheavy) transpose_item(p, 4352 + it * 4, tid_, shm); }
    }
    PHASE_SYNC(5);
    if (PHASE_ON(5)) REP(5) {
        pg8::StaticOrder S; S.init(MTOK, DM, gridDim.x, blockIdx.x, 2, 192);
        EpiMerge<true> E{Gt, Mb};
        pg8::gemm_phase<EpiMerge<true>, true, true>((LAS unsigned char*)shm, pg8::Gemm{Ob, WbrT, MTOK, DM, 1024, DM}, S, E);
        W_DOWN_PART(0);
    }
    PHASE_SYNC(6);
    if (PHASE_ON(6)) REP(6) {
        pg8::StaticOrder S; S.init(MTOK, DM, gridDim.x, blockIdx.x, 1, 192);
        EpiRes<true, false, true> E{p.x_prompt, p.x_sample, mod, 4096, X1};
        pg8::gemm_phase<EpiRes<true, false, true>, false, true>((LAS unsigned char*)shm, pg8::Gemm{Mb, WoutT, MTOK, DM, DM, DM}, S, E);
        W_DOWN_PART(1);
    }
    PHASE_SYNC(7);
    if (PHASE_ON(7)) REP(7) NORM_PHASE(false);
    PHASE_SYNC(8);
    if (PHASE_ON(8)) REP(8) {
        pg8::StaticOrder S; S.init(MTOK, DFF, gridDim.x, blockIdx.x);
        EpiUp E{Ub};
        pg8::gemm_phase((LAS unsigned char*)shm, pg8::Gemm{Hb, WupT, MTOK, DFF, DM, DM}, S, E);
    }
    PHASE_SYNC(9);
    if (PHASE_ON(9)) REP(9) {
        pg8::StaticOrder S; S.init(MTOK, DM, gridDim.x, blockIdx.x, 1, 192);
        EpiRes<true, true, false> E{X1, X1 + (size_t)NPROMPT * DM, mod, 10240, p.out + OUT_YP};
        pg8::gemm_phase<EpiRes<true, true, false>, false, true>((LAS unsigned char*)shm, pg8::Gemm{Ub, WdownT, MTOK, DM, DFF, DFF}, S, E);
    }
}

extern "C" void kernel_launch(void* const* d_in, const int* in_sizes, int n_in, void* d_out, int out_size, void* d_ws, size_t ws_size, hipStream_t stream) {
    static int grid_blocks = 0;
    if (!grid_blocks) {
        if (n_in != 24 || ws_size < WS_END) { fprintf(stderr, "kernel_launch: unexpected n_in %d / ws_size %zu (need %zu)\n", n_in, ws_size, (size_t)WS_END); return; }
        int dev = 0, cus = 0, per_cu = 0;
        hipGetDevice(&dev);
        hipDeviceGetAttribute(&cus, hipDeviceAttributeMultiprocessorCount, dev);
        if (hipFuncSetAttribute((const void*)fwd_megakernel, hipFuncAttributeMaxDynamicSharedMemorySize, LDS_BYTES) != hipSuccess) { fprintf(stderr, "kernel_launch: hipFuncSetAttribute failed\n"); return; }
        hipOccupancyMaxActiveBlocksPerMultiprocessor(&per_cu, (const void*)fwd_megakernel, 512, LDS_BYTES);
        if (per_cu < 1) per_cu = 1;
        grid_blocks = cus;
    }
    Params p{};
    const float** f = (const float**)&p;
    for (int i = 0; i < 24; ++i) f[i] = (const float*)d_in[i];
    p.out = (float*)d_out; p.ws = (char*)d_ws; p.ph_lo = 0; p.ph_hi = 9;
    hipMemsetAsync((char*)d_ws + WS_BAR, 0, 16384, stream);
    void* args[] = {&p};
    hipError_t e = hipLaunchCooperativeKernel((const void*)fwd_megakernel, dim3(grid_blocks), dim3(512), args, LDS_BYTES, stream);
    if (e != hipSuccess) fprintf(stderr, "cooperative launch failed: %s (grid %d)\n", hipGetErrorString(e), grid_blocks);
}
```
